# Optimizing an MI355X kernel written in HIP

```python
import jax, jax.numpy as jnp
from jax import lax
import numpy as np

D_MODEL = 1024
BATCH = 16
SEQ = 4096
DEPTH = 1
DEC_BATCH = 2
DEC_SEQ = 8192
PAST_LEN = 128

MIX_WIDTH = D_MODEL
POOL_WIDTH = MIX_WIDTH // 2
ATTN_WIDTH = MIX_WIDTH - POOL_WIDTH
POOL_WINDOWS = (2, 4, 8, 16)
N_POOL_GROUPS = len(POOL_WINDOWS)
POOL_GROUP_DIM = POOL_WIDTH // N_POOL_GROUPS
HEAD_DIM = 64
N_HEADS = ATTN_WIDTH // HEAD_DIM
GRID_W = 64
WIN_ROWS_MAX = 8
WIN_COLS = 16
RPB_ROWS = 2 * WIN_ROWS_MAX - 1
RPB_COLS = 2 * WIN_COLS - 1
IN_WIDTH = 2 * POOL_WIDTH + 4 * ATTN_WIDTH
EPS = 1e-6

kernel_name = "hymba_pool_natten_encoder"


def rms_norm(x, g):
    xf = x.astype(jnp.float32)
    y = xf * lax.rsqrt(jnp.mean(xf * xf, axis=-1, keepdims=True) + EPS)
    return (y * g.astype(jnp.float32)).astype(x.dtype)


def centred_window_mean(u, w):
    B, S, C = u.shape
    a = w // 2
    b = w - a
    csum = jnp.cumsum(u.astype(jnp.float32), axis=1)
    csum = jnp.concatenate([jnp.zeros((B, 1, C), jnp.float32), csum], axis=1)
    cpad = jnp.pad(csum, ((0, 0), (a, b), (0, 0)), mode="edge")
    window_sum = cpad[:, w:w + S] - cpad[:, 0:S]
    t = jnp.arange(S)
    count = (jnp.minimum(t + b, S) - jnp.maximum(t - a, 0)).astype(jnp.float32)
    return window_sum / count[None, :, None]


def pool_mixer(u, w_pool, pool_scale):
    B, S, _ = u.shape
    ug = u.reshape(B, S, N_POOL_GROUPS, POOL_GROUP_DIM)
    pooled = jnp.stack(
        [centred_window_mean(ug[:, :, g], w) - ug[:, :, g].astype(jnp.float32)
         for g, w in enumerate(POOL_WINDOWS)], axis=2)
    mixed = jnp.einsum("bsgc,gcd->bsgd", pooled.astype(u.dtype), w_pool)
    return mixed.reshape(B, S, POOL_WIDTH) * pool_scale


def neighbourhood_attention(q, k, v, rpb):
    B, S, H, Dh = q.shape
    rows = S // GRID_W
    kr = min(WIN_ROWS_MAX, rows)
    qg = q.reshape(B, rows, GRID_W, H, Dh)
    kg = k.reshape(B, rows, GRID_W, H, Dh)
    vg = v.reshape(B, rows, GRID_W, H, Dh)
    col = np.arange(GRID_W)
    col_start = np.clip(col - WIN_COLS // 2, 0, GRID_W - WIN_COLS)
    col_idx = col_start[:, None] + np.arange(WIN_COLS)[None, :]
    col_off = col_idx - col[:, None] + (WIN_COLS - 1)
    bias_cols = rpb[:, :, col_off]

    def row_block(r):
        rs = jnp.clip(r - kr // 2, 0, rows - kr)
        q_r = lax.dynamic_index_in_dim(qg, r, axis=1, keepdims=False)
        k_r = lax.dynamic_slice_in_dim(kg, rs, kr, axis=1)
        v_r = lax.dynamic_slice_in_dim(vg, rs, kr, axis=1)
        k_w = k_r[:, :, col_idx]
        v_w = v_r[:, :, col_idx]
        s = jnp.einsum("bchd,bicjhd->bhcij", q_r, k_w).astype(jnp.float32)
        row_off = rs + jnp.arange(kr) - r + (WIN_ROWS_MAX - 1)
        bias = jnp.take(bias_cols, row_off, axis=1)
        s = s + jnp.transpose(bias, (0, 2, 1, 3)).astype(jnp.float32)[None]
        p = jax.nn.softmax(s.reshape(B, H, GRID_W, kr * WIN_COLS), axis=-1)
        p = p.reshape(B, H, GRID_W, kr, WIN_COLS).astype(v.dtype)
        return jnp.einsum("bhcij,bicjhd->bchd", p, v_w)

    out = lax.map(row_block, jnp.arange(rows))
    return jnp.transpose(out, (1, 0, 2, 3, 4)).reshape(B, S, H * Dh)


def encoder_layer(x, norm_g, w_in, w_pool, pool_scale, q_norm_g, k_norm_g, rpb, w_out):
    B, S, _ = x.shape
    h = rms_norm(x, norm_g)
    proj = h @ w_in
    P, A = POOL_WIDTH, ATTN_WIDTH
    u_pool, g_pool, q, k, v, g_attn = jnp.split(
        proj, [P, 2 * P, 2 * P + A, 2 * P + 2 * A, 2 * P + 3 * A], axis=-1)
    pool_out = pool_mixer(u_pool, w_pool, pool_scale) * jax.nn.silu(g_pool)
    q = rms_norm(q.reshape(B, S, N_HEADS, HEAD_DIM), q_norm_g) * (HEAD_DIM ** -0.5)
    k = rms_norm(k.reshape(B, S, N_HEADS, HEAD_DIM), k_norm_g)
    v = v.reshape(B, S, N_HEADS, HEAD_DIM)
    attn_out = neighbourhood_attention(q, k, v, rpb) * jax.nn.silu(g_attn)
    mixed = jnp.concatenate([pool_out, attn_out], axis=-1)
    return x + mixed @ w_out


def setup_inputs(seed: int = 0) -> dict:
    key = jax.random.key(seed)
    ks = jax.random.split(key, 11)
    f32 = jnp.float32
    x_prompt = jax.random.normal(ks[0], (BATCH, SEQ, D_MODEL), f32)
    x_sample = jax.random.normal(ks[1], (DEC_BATCH, DEC_SEQ, D_MODEL), f32)
    norm_g = 1.0 + 0.02 * jax.random.normal(ks[2], (DEPTH, D_MODEL), f32)
    w_in = jax.random.normal(ks[3], (DEPTH, D_MODEL, IN_WIDTH), f32) * D_MODEL ** -0.5
    w_pool = jax.random.normal(ks[4], (DEPTH, N_POOL_GROUPS, POOL_GROUP_DIM, POOL_GROUP_DIM), f32) * POOL_GROUP_DIM ** -0.5
    pool_scale = 1.0 + 0.02 * jax.random.normal(ks[5], (DEPTH, POOL_WIDTH), f32)
    q_norm_g = 1.0 + 0.02 * jax.random.normal(ks[6], (DEPTH, HEAD_DIM), f32)
    k_norm_g = 1.0 + 0.02 * jax.random.normal(ks[7], (DEPTH, HEAD_DIM), f32)
    rpb = 0.1 * jax.random.normal(ks[8], (DEPTH, N_HEADS, RPB_ROWS, RPB_COLS), f32)
    w_out = jax.random.normal(ks[9], (DEPTH, MIX_WIDTH, D_MODEL), f32) * MIX_WIDTH ** -0.5
    return {"x_prompt": x_prompt, "x_sample": x_sample, "norm_g": norm_g, "w_in": w_in,
            "w_pool": w_pool, "pool_scale": pool_scale, "q_norm_g": q_norm_g,
            "k_norm_g": k_norm_g, "rpb": rpb, "w_out": w_out}


def reference(x_prompt, x_sample, norm_g, w_in, w_pool, pool_scale, q_norm_g, k_norm_g, rpb, w_out):
    y_prompt = x_prompt
    y_sample = x_sample
    for l in range(DEPTH):
        y_prompt = encoder_layer(y_prompt, norm_g[l], w_in[l], w_pool[l], pool_scale[l],
                                 q_norm_g[l], k_norm_g[l], rpb[l], w_out[l])
        y_sample = encoder_layer(y_sample, norm_g[l], w_in[l], w_pool[l], pool_scale[l],
                                 q_norm_g[l], k_norm_g[l], rpb[l], w_out[l])
    return (y_prompt, y_sample)
```

```cpp
#include <hip/hip_runtime.h>
#include <hip/hip_cooperative_groups.h>
#include <cstdio>
namespace cg = cooperative_groups;

#define LAS __attribute__((address_space(3)))
typedef unsigned short bf16_t;
typedef short bf16x8 __attribute__((ext_vector_type(8)));
typedef float f32x4 __attribute__((ext_vector_type(4)));
typedef unsigned u32x4 __attribute__((ext_vector_type(4)));
typedef unsigned u32x2 __attribute__((ext_vector_type(2)));

namespace {
constexpr int NTOK = 81920, NTOK_P = 65536;
constexpr float EPS = 1e-6f;
constexpr int BM = 256, BK = 64, HALF = 128, HTB = HALF * BK * 2, STAGE_BYTES = 8 * HTB;
constexpr int LDS_BYTES = 147456 + 8 * 465 * 4 + 16;
constexpr size_t ACT_STRIDE = (size_t)NTOK * 512;
constexpr size_t WS_XB = 0;
constexpr size_t WS_RS = WS_XB + (size_t)NTOK * 1024 * 2;
constexpr size_t WS_WIN = WS_RS + (size_t)NTOK * 4;
constexpr size_t WS_WOUT = WS_WIN + (size_t)3072 * 1024 * 2;
constexpr size_t WS_WP = WS_WOUT + (size_t)1024 * 1024 * 2;
constexpr size_t WS_ACT = WS_WP + (size_t)4 * 128 * 128 * 2;
constexpr size_t WS_VT = WS_ACT + 5 * ACT_STRIDE * 2;
constexpr size_t WS_MIX = WS_VT + ACT_STRIDE * 2;
constexpr size_t WS_RSI = WS_MIX + (size_t)NTOK * 1024 * 2;
constexpr size_t WS_ID = WS_RSI + (size_t)NTOK * 4;
constexpr size_t WS_BAR = WS_ID + (size_t)256 * 1024 * 2;
constexpr size_t WS_END = WS_BAR + 16384;

struct Params {
    const float* xp; const float* xs; const float* norm_g; const float* w_in; const float* w_pool; const float* pool_scale;
    const float* qg; const float* kg; const float* rpb; const float* w_out; float* out; unsigned char* ws;
    int ph_lo, ph_hi, coop, use_cg;
};
#define XB_TMO      128
#define XB_XCNT(j)  (256  + 64 * (j))
#define XB_XSUB(j)  (1280 + 64 * (j))
#define XB_XGEN(j)  (2304 + 64 * (j))
#define XB_TOP      3328
#define XB_TOPGEN   3392
#define XCD_BAR_WORDS 3456
#define XB_SPIN_CAP (1u << 22)
__device__ __forceinline__ unsigned xb_ld(unsigned* p)              { return __hip_atomic_load(p, __ATOMIC_RELAXED, __HIP_MEMORY_SCOPE_AGENT); }
__device__ __forceinline__ unsigned xb_add(unsigned* p, unsigned v) { return __hip_atomic_fetch_add(p, v, __ATOMIC_RELAXED, __HIP_MEMORY_SCOPE_AGENT); }
__device__ __forceinline__ unsigned xb_xcc_id() { return (unsigned)__builtin_amdgcn_s_getreg((3 << 11) | 20) & 0xFu; }
#define XB_SPIN(cond, bar) do { unsigned _sp = 0; while (cond) { __builtin_amdgcn_s_sleep(1); \
    if ((++_sp & 255u) == 0u) { if (xb_ld(&(bar)[XB_TMO])) break; if (_sp > XB_SPIN_CAP) { atomicAdd(&(bar)[XB_TMO], 1u); break; } } } } while (0)
struct XcdBarrier { unsigned* bar; unsigned x; volatile LAS unsigned* st; };
__device__ __forceinline__ XcdBarrier xcd_barrier_post(unsigned* bar, volatile LAS unsigned* st) {
    XcdBarrier b; b.bar = bar; b.x = xb_xcc_id(); b.st = st;
    if (threadIdx.x == 0) (void)xb_add(&bar[XB_XCNT(b.x)], 1u);
    return b;
}
__device__ __forceinline__ void xcd_barrier_complete(unsigned* bar, unsigned x, unsigned& nloc, unsigned& nx) {
    const unsigned G = gridDim.x * gridDim.y * gridDim.z;
    unsigned sum, cnt, mine, sp = 0u;
    for (;;) {
        sum = 0u; cnt = 0u; mine = 0u;
#pragma unroll
        for (unsigned j = 0; j < 16; ++j) { const unsigned c = xb_ld(&bar[XB_XCNT(j)]); sum += c; cnt += (c > 0u) ? 1u : 0u; mine = (j == x) ? c : mine; }
        if (sum == G) break;
        __builtin_amdgcn_s_sleep(1);
        if ((++sp & 255u) == 0u) { if (xb_ld(&bar[XB_TMO])) break; if (sp > XB_SPIN_CAP) { atomicAdd(&bar[XB_TMO], 1u); break; } }
    }
    nloc = mine > 0u ? mine : 1u; nx = cnt > 0u ? cnt : 1u;
}
__device__ __forceinline__ void xcd_barrier(const XcdBarrier& b) {
    asm volatile("s_waitcnt vmcnt(0) lgkmcnt(0)" ::: "memory");
    __syncthreads();
    if (threadIdx.x == 0) {
        unsigned* bar = b.bar;
        __builtin_amdgcn_s_waitcnt(0);
        unsigned nloc = b.st[0], nx = b.st[1];
        if (nloc == 0u) { xcd_barrier_complete(bar, b.x, nloc, nx); b.st[0] = nloc; b.st[1] = nx; }
        const unsigned old = xb_add(&bar[XB_XSUB(b.x)], 1u);
        const unsigned gen = old / nloc;
        if (old + 1u == (gen + 1u) * nloc) {
            __builtin_amdgcn_fence(__ATOMIC_RELEASE, "agent");
            asm volatile("s_waitcnt vmcnt(0)" ::: "memory");
            const unsigned og = xb_add(&bar[XB_TOP], 1u);
            const unsigned tg = og / nx;
            if (og + 1u == (tg + 1u) * nx) xb_add(&bar[XB_TOPGEN], 1u);
            else XB_SPIN(xb_ld(&bar[XB_TOPGEN]) == tg, bar);
            __builtin_amdgcn_fence(__ATOMIC_ACQUIRE, "agent");
            xb_add(&bar[XB_XGEN(b.x)], 1u);
            asm volatile("s_waitcnt vmcnt(0)" ::: "memory");
        } else {
            XB_SPIN(xb_ld(&bar[XB_XGEN(b.x)]) == gen, bar);
            __builtin_amdgcn_fence(__ATOMIC_ACQUIRE, "agent");
            asm volatile("s_waitcnt vmcnt(0)" ::: "memory");
        }
    }
    __syncthreads();
}

__device__ __forceinline__ unsigned cvt_pk_bf16(float lo, float hi) { unsigned r; asm("v_cvt_pk_bf16_f32 %0, %1, %2" : "=v"(r) : "v"(lo), "v"(hi)); return r; }
__device__ __forceinline__ float bf_lo(unsigned w) { return __uint_as_float(w << 16); }
__device__ __forceinline__ float bf_hi(unsigned w) { return __uint_as_float(w & 0xffff0000u); }
typedef unsigned xr_u2 __attribute__((ext_vector_type(2)));
__device__ __forceinline__ float xsum4(float x) {
    xr_u2 r = __builtin_amdgcn_permlane32_swap(__float_as_uint(x), __float_as_uint(x), false, false); const float s = __uint_as_float(r.x) + __uint_as_float(r.y);
    xr_u2 q = __builtin_amdgcn_permlane16_swap(__float_as_uint(s), __float_as_uint(s), false, false); return __uint_as_float(q.x) + __uint_as_float(q.y);
}
__device__ __forceinline__ float xmax4(float x) {
    xr_u2 r = __builtin_amdgcn_permlane32_swap(__float_as_uint(x), __float_as_uint(x), false, false); const float s = fmaxf(__uint_as_float(r.x), __uint_as_float(r.y));
    xr_u2 q = __builtin_amdgcn_permlane16_swap(__float_as_uint(s), __float_as_uint(s), false, false); return fmaxf(__uint_as_float(q.x), __uint_as_float(q.y));
}
__device__ __forceinline__ float silu_f(float v) { return v * __builtin_amdgcn_rcpf(1.0f + __expf(-v)); }

__device__ __forceinline__ int lds_byte(int r, int c) { const int st = (r >> 4) * 2 + (c >> 5), rr = r & 15, cc = c & 31, ob = rr * 64 + cc * 2; return st * 1024 + (ob ^ (((ob >> 9) & 1) << 5)); }
__device__ __forceinline__ void stage_rc(int b, int& R, int& C) { const int st = b / 1024, sb = b % 1024, swz = sb ^ (((sb >> 9) & 1) << 5); R = (st >> 1) * 16 + swz / 64; C = (st & 1) * 32 + (swz % 64) / 2; }
__device__ __forceinline__ int perm32(int rho) { const int n = rho >> 4, i = rho & 15; return 8 * (i >> 2) + 4 * n + (i & 3); }

struct Unit { int pm, pn; };
template <int nM, int nN> __device__ __forceinline__ bool unit_next(int i, int G, int c, Unit& u) {
    constexpr int nwg = nM * nN; const long L = (long)i * G + c; if (L >= nwg) return false;
    int wgid = (int)L; { constexpr int q = nwg / 8, r = nwg % 8; const int xcd = wgid % 8, off = wgid / 8; wgid = (xcd < r ? xcd * (q + 1) : r * (q + 1) + (xcd - r) * q) + off; }
    constexpr int nig = 8 * nN; const int gid = wgid / nig, fm = gid * 8, gsz = (nM - fm) < 8 ? (nM - fm) : 8;
    u.pm = fm + ((wgid % nig) % gsz); u.pn = (wgid % nig) / gsz; return true;
}

__device__ __forceinline__ void prep_phase(const Params& p, int G) {
    const int tid = threadIdx.x, lane = tid & 63, wid = tid >> 6;
    bf16_t* xb = (bf16_t*)(p.ws + WS_XB); float* rsb = (float*)(p.ws + WS_RS); float* rsib = (float*)(p.ws + WS_RSI);
    const int nw = G * 8;
#define PREP_LOAD(dst, row) do { const float* _xr = ((row) < NTOK_P) ? p.xp + (size_t)(row) * 1024 : p.xs + (size_t)((row) - NTOK_P) * 1024; \
        dst[0] = __builtin_nontemporal_load((const f32x4*)(_xr + lane * 8)); dst[1] = __builtin_nontemporal_load((const f32x4*)(_xr + lane * 8 + 4)); \
        dst[2] = __builtin_nontemporal_load((const f32x4*)(_xr + 512 + lane * 8)); dst[3] = __builtin_nontemporal_load((const f32x4*)(_xr + 512 + lane * 8 + 4)); } while (0)
#define PREP_DO(v, row) do { float ss = 0.f; \
        _Pragma("unroll") for (int k = 0; k < 4; ++k) _Pragma("unroll") for (int j = 0; j < 4; ++j) ss += v[k][j] * v[k][j]; \
        _Pragma("unroll") for (int o = 32; o >= 1; o >>= 1) ss += __shfl_xor(ss, o); \
        const float rsc = rsqrtf(ss * (1.0f / 1024.0f) + EPS); u32x4 w0, w1; if (lane == 0) { rsb[row] = rsc; rsib[row] = sqrtf(ss * (1.0f / 1024.0f) + EPS); } \
        w0.x = cvt_pk_bf16(v[0][0] * rsc, v[0][1] * rsc); w0.y = cvt_pk_bf16(v[0][2] * rsc, v[0][3] * rsc); w0.z = cvt_pk_bf16(v[1][0] * rsc, v[1][1] * rsc); w0.w = cvt_pk_bf16(v[1][2] * rsc, v[1][3] * rsc); \
        w1.x = cvt_pk_bf16(v[2][0] * rsc, v[2][1] * rsc); w1.y = cvt_pk_bf16(v[2][2] * rsc, v[2][3] * rsc); w1.z = cvt_pk_bf16(v[3][0] * rsc, v[3][1] * rsc); w1.w = cvt_pk_bf16(v[3][2] * rsc, v[3][3] * rsc); \
        *(u32x4*)(xb + (size_t)(row) * 1024 + lane * 8) = w0; *(u32x4*)(xb + (size_t)(row) * 1024 + 512 + lane * 8) = w1; } while (0)
    {
        int row = blockIdx.x * 8 + wid;
        f32x4 va[4], vb[4], vc[4];
        if (row < NTOK) PREP_LOAD(va, row);
        if (row + nw < NTOK) PREP_LOAD(vb, row + nw);
        for (; row < NTOK; row += 3 * nw) {
            if (row + 2 * nw < NTOK) PREP_LOAD(vc, row + 2 * nw);
            PREP_DO(va, row);
            if (row + nw < NTOK) { if (row + 3 * nw < NTOK) PREP_LOAD(va, row + 3 * nw); PREP_DO(vb, row + nw); }
            if (row + 2 * nw < NTOK) { if (row + 4 * nw < NTOK) PREP_LOAD(vb, row + 4 * nw); PREP_DO(vc, row + 2 * nw); }
        }
    }
#undef PREP_LOAD
#undef PREP_DO
    const int gt = blockIdx.x * 512 + tid, T = G * 512;
    bf16_t* WinT = (bf16_t*)(p.ws + WS_WIN); bf16_t* WoutT = (bf16_t*)(p.ws + WS_WOUT); bf16_t* WpT = (bf16_t*)(p.ws + WS_WP);
    for (int idx = gt; idx < 3072 * 128; idx += T) {
        const int n = idx % 3072, k8 = idx / 3072; float v[8];
#pragma unroll
        for (int j = 0; j < 8; ++j) v[j] = p.w_in[(size_t)(k8 * 8 + j) * 3072 + n] * p.norm_g[k8 * 8 + j];
        u32x4 w; w.x = cvt_pk_bf16(v[0], v[1]); w.y = cvt_pk_bf16(v[2], v[3]); w.z = cvt_pk_bf16(v[4], v[5]); w.w = cvt_pk_bf16(v[6], v[7]);
        *(u32x4*)(WinT + (size_t)n * 1024 + k8 * 8) = w;
    }
    for (int idx = gt; idx < 1024 * 128; idx += T) {
        const int n = idx % 1024, k8 = idx / 1024; float v[8];
#pragma unroll
        for (int j = 0; j < 8; ++j) v[j] = p.w_out[(size_t)(k8 * 8 + j) * 1024 + n];
        u32x4 w; w.x = cvt_pk_bf16(v[0], v[1]); w.y = cvt_pk_bf16(v[2], v[3]); w.z = cvt_pk_bf16(v[4], v[5]); w.w = cvt_pk_bf16(v[6], v[7]);
        *(u32x4*)(WoutT + (size_t)n * 1024 + k8 * 8) = w;
    }
    for (int idx = gt; idx < 256 * 128; idx += T) {
        const int n = idx >> 7, k8 = idx & 127; u32x4 w = (u32x4){0u, 0u, 0u, 0u};
        if (k8 == (n >> 3)) { const unsigned one = 0x3F80u << (16 * (n & 1)); const int wd = (n & 7) >> 1; w.x = wd == 0 ? one : 0u; w.y = wd == 1 ? one : 0u; w.z = wd == 2 ? one : 0u; w.w = wd == 3 ? one : 0u; }
        *(u32x4*)((bf16_t*)(p.ws + WS_ID) + (size_t)n * 1024 + k8 * 8) = w;
    }
    for (int idx = gt; idx < 4 * 128 * 16; idx += T) {
        const int d = idx % 128, c8 = (idx / 128) % 16, g = idx / 2048; float v[8];
#pragma unroll
        for (int j = 0; j < 8; ++j) v[j] = p.w_pool[(size_t)(g * 128 + c8 * 8 + j) * 128 + d];
        u32x4 w; w.x = cvt_pk_bf16(v[0], v[1]); w.y = cvt_pk_bf16(v[2], v[3]); w.z = cvt_pk_bf16(v[4], v[5]); w.w = cvt_pk_bf16(v[6], v[7]);
        *(u32x4*)(WpT + (size_t)(g * 128 + d) * 128 + c8 * 8) = w;
    }
}

__device__ __forceinline__ void epi_gemm1(const f32x4 (&acc)[2][2][4][2], const Unit& u, int wr, int wc, int fr, int fq, const Params& p) {
    if (u.pn == 8 || u.pn == 9) {
        bf16_t* VT = (bf16_t*)(p.ws + WS_VT);
        const int gr = u.pm * 4 + wc;
#pragma unroll
        for (int ai = 0; ai < 2; ++ai)
#pragma unroll
            for (int m = 0; m < 4; ++m) {
                const int vc = (u.pn - 8) * 256 + ai * 128 + wr * 64 + m * 16 + fr; const int h = vc >> 6, d = vc & 63;
                bf16_t* dst = VT + ((size_t)(gr * 8 + h) * 64 + d) * 64 + fq * 8;
#pragma unroll
                for (int bj = 0; bj < 2; ++bj) { const f32x4 v0 = acc[ai][bj][m][0], v1 = acc[ai][bj][m][1];
                    u32x4 w; w.x = cvt_pk_bf16(v0[0], v0[1]); w.y = cvt_pk_bf16(v0[2], v0[3]); w.z = cvt_pk_bf16(v1[0], v1[1]); w.w = cvt_pk_bf16(v1[2], v1[3]);
                    __builtin_nontemporal_store(w, (u32x4*)(dst + 32 * bj)); }
            }
    } else {
        const int kind = u.pn < 8 ? (u.pn >> 1) : 4;
        bf16_t* base = (bf16_t*)(p.ws + WS_ACT) + (size_t)kind * ACT_STRIDE;
        const int row0 = u.pm * 256 + wr * 64 + fr, col0 = (u.pn & 1) * 256 + wc * 64 + fq * 8;
        f32x4 gv[2][2];
        if (kind == 2 || kind == 3) { const float* g = kind == 2 ? p.qg : p.kg; const float sc = kind == 2 ? 0.125f : 1.0f;
#pragma unroll
            for (int bj = 0; bj < 2; ++bj)
#pragma unroll
                for (int n = 0; n < 2; ++n) gv[bj][n] = *(const f32x4*)(g + 32 * bj + 8 * fq + 4 * n) * sc; }
#pragma unroll
        for (int ai = 0; ai < 2; ++ai)
#pragma unroll
            for (int m = 0; m < 4; ++m) {
                const int row = row0 + ai * 128 + m * 16;
                f32x4 v[2][2];
#pragma unroll
                for (int bj = 0; bj < 2; ++bj)
#pragma unroll
                    for (int n = 0; n < 2; ++n) v[bj][n] = acc[ai][bj][m][n];
                if (kind == 2 || kind == 3) {
                    float ss = 0.f;
#pragma unroll
                    for (int bj = 0; bj < 2; ++bj)
#pragma unroll
                        for (int n = 0; n < 2; ++n) { const f32x4 x = v[bj][n]; ss += (x[0] * x[0] + x[1] * x[1]) + (x[2] * x[2] + x[3] * x[3]); }
                    ss = xsum4(ss);
                    const float sc = rsqrtf(ss * (1.0f / 64.0f) + EPS);
#pragma unroll
                    for (int bj = 0; bj < 2; ++bj)
#pragma unroll
                        for (int n = 0; n < 2; ++n) v[bj][n] = v[bj][n] * gv[bj][n] * sc;
                } else if (kind == 1 || kind == 4) {
#pragma unroll
                    for (int bj = 0; bj < 2; ++bj)
#pragma unroll
                        for (int n = 0; n < 2; ++n)
#pragma unroll
                            for (int j = 0; j < 4; ++j) v[bj][n][j] = silu_f(v[bj][n][j]);
                }
                bf16_t* dst = base + (size_t)row * 512 + col0;
#pragma unroll
                for (int bj = 0; bj < 2; ++bj) { u32x4 w; w.x = cvt_pk_bf16(v[bj][0][0], v[bj][0][1]); w.y = cvt_pk_bf16(v[bj][0][2], v[bj][0][3]); w.z = cvt_pk_bf16(v[bj][1][0], v[bj][1][1]); w.w = cvt_pk_bf16(v[bj][1][2], v[bj][1][3]);
                    __builtin_nontemporal_store(w, (u32x4*)(dst + 32 * bj)); }
            }
    }
}
__device__ __forceinline__ void epi_gemm2(const f32x4 (&acc)[2][2][4][2], const Unit& u, int wr, int wc, int fr, int fq, const Params& p) {
    const int row0 = u.pm * 256 + wr * 64 + fr, col0 = u.pn * 256 + wc * 32 + 4 * fq;
    const float* rsi = (const float*)(p.ws + WS_RSI) + row0; float ri[2][4];
#pragma unroll
    for (int ai = 0; ai < 2; ++ai)
#pragma unroll
        for (int m = 0; m < 4; ++m) ri[ai][m] = rsi[ai * 128 + m * 16];
#pragma unroll
    for (int ai = 0; ai < 2; ++ai)
#pragma unroll
        for (int m = 0; m < 4; ++m) {
            const int row = row0 + ai * 128 + m * 16;
            float* orow = p.out + (size_t)row * 1024 + col0;
#pragma unroll
            for (int bj = 0; bj < 2; ++bj)
#pragma unroll
                for (int n = 0; n < 2; ++n) *(f32x4*)(orow + bj * 128 + n * 16) = acc[ai][bj][m][n] * ri[ai][m];
        }
}

template <int MODE> __device__ __forceinline__ void acc_init(f32x4 (&acc)[2][2][4][2], const Unit& u, int wr, int wc, int fr, int fq, const Params& p) {
    if (MODE == 0) {
#pragma unroll
        for (int a = 0; a < 2; ++a)
#pragma unroll
            for (int b = 0; b < 2; ++b)
#pragma unroll
                for (int m = 0; m < 4; ++m)
#pragma unroll
                    for (int n = 0; n < 2; ++n) acc[a][b][m][n] = (f32x4){0.f, 0.f, 0.f, 0.f};
    } else {
#pragma unroll
        for (int a = 0; a < 2; ++a)
#pragma unroll
            for (int b = 0; b < 2; ++b)
#pragma unroll
                for (int m = 0; m < 4; ++m)
#pragma unroll
                    for (int n = 0; n < 2; ++n) acc[a][b][m][n] = (f32x4){0.f, 0.f, 0.f, 0.f};
    }
}
template <int MODE>
__device__ __forceinline__ void gemm_phase(LAS unsigned char* lds, const Params& p, const int G, const int c) {
    constexpr int K = 1024, nt = (MODE == 0 ? 16 : 20);
    constexpr int nM = NTOK / 256, nN = (MODE == 0 ? 12 : 4);
    const char* Aop = (const char*)(p.ws + (MODE == 0 ? WS_XB : WS_MIX));
    const char* idm = (const char*)(p.ws + WS_ID) - 16 * (size_t)(BK * 2);
    const char* Bop = (const char*)(p.ws + (MODE == 0 ? WS_WIN : WS_WOUT));
    const int tid = threadIdx.x, wid = __builtin_amdgcn_readfirstlane(tid >> 6), lane = tid & 63, wr = wid >> 2, wc = wid & 3, fr = lane & 15, fq = lane >> 4;
    unsigned voffA[2], voffB[2];
#pragma unroll
    for (int i = 0; i < 2; ++i) { int R, C; stage_rc(tid * 16 + i * 8192, R, C); const int Rb = (MODE == 0) ? (64 * (R >> 5) + perm32(R & 31)) : R;
        voffA[i] = (unsigned)(R * K + C) * 2u; voffB[i] = (unsigned)(Rb * K + C) * 2u; }
    constexpr size_t kstep = (size_t)(BK * 2);
    constexpr size_t hstepA = (size_t)HALF * K * 2;
    constexpr size_t hstepB = (size_t)(MODE == 0 ? 32 : 128) * K * 2;
    constexpr size_t tstep = (size_t)256 * K * 2;
    const unsigned ldsw = (unsigned)wid * 1024u;
    const int aoff = lds_byte(wr * 64 + fr, fq * 8), boff = lds_byte(wc * 32 + fr, fq * 8);
#define PG8_SA(b, h) (((b) * 2 + (h)) * HTB)
#define PG8_SB(b, h) ((4 + (b) * 2 + (h)) * HTB)
#define PG8_STAGE(bufoff, gbase, voff) do { _Pragma("unroll") for (int _i = 0; _i < 2; ++_i) \
        __builtin_amdgcn_global_load_lds((const unsigned*)((const char*)(gbase) + (voff)[_i]), (LAS unsigned*)(lds + (bufoff) + ldsw + _i * 8192), 16, 0, 0); } while (0)
#define PG8_LDA(dst, b, h) do { _Pragma("unroll") for (int m = 0; m < 4; ++m) _Pragma("unroll") for (int k = 0; k < 2; ++k) dst[m][k] = *(const LAS bf16x8*)(lds + PG8_SA(b, h) + aoff + m * 2048 + k * 1024); } while (0)
#define PG8_LDB(dst, b, h) do { _Pragma("unroll") for (int n = 0; n < 2; ++n) _Pragma("unroll") for (int k = 0; k < 2; ++k) dst[n][k] = *(const LAS bf16x8*)(lds + PG8_SB(b, h) + boff + n * 2048 + k * 1024); } while (0)
#define PG8_MMA(ai, bj, At, Bt) do { __builtin_amdgcn_s_setprio(1); _Pragma("unroll") for (int m = 0; m < 4; ++m) _Pragma("unroll") for (int n = 0; n < 2; ++n) _Pragma("unroll") for (int k = 0; k < 2; ++k) \
        acc[ai][bj][m][n] = __builtin_amdgcn_mfma_f32_16x16x32_bf16(Bt[n][k], At[m][k], acc[ai][bj][m][n], 0, 0, 0); __builtin_amdgcn_s_setprio(0); } while (0)
#define PG8_WAIT_V(n) asm volatile("s_waitcnt vmcnt(" #n ")" ::: "memory")
#define PG8_WAIT_L(n) asm volatile("s_waitcnt lgkmcnt(" #n ")" ::: "memory")
#define PG8_BAR __builtin_amdgcn_s_barrier()
#define PG8_SCHED __builtin_amdgcn_sched_barrier(0)
#define UNIT_PTRS(u, pa, pb) do { if (MODE == 0 && ((u).pn == 8 || (u).pn == 9)) { pa = Bop + (size_t)(u).pn * tstep; pb = Aop + (size_t)(u).pm * tstep; } \
        else { pa = Aop + (size_t)(u).pm * tstep; pb = Bop + (size_t)(u).pn * tstep; } } while (0)
    Unit cur, nxt; int ui = 0;
    if (!unit_next<nM, nN>(0, G, c, cur)) return;
    f32x4 acc[2][2][4][2];
    acc_init<MODE>(acc, cur, wr, wc, fr, fq, p);
    bf16x8 At[4][2], B0[2][2], B1[2][2];
    const char* cA; const char* cB; UNIT_PTRS(cur, cA, cB);
#define UNIT_X(u) ((const char*)(p.ws + WS_XB) + (size_t)(u).pm * tstep + (size_t)(u).pn * 512 - 16 * kstep)
    const char* cX = UNIT_X(cur);
    PG8_STAGE(PG8_SB(0, 0), cB, voffB); PG8_STAGE(PG8_SA(0, 0), cA, voffA); PG8_STAGE(PG8_SB(0, 1), cB + hstepB, voffB); PG8_STAGE(PG8_SA(0, 1), cA + hstepA, voffA);
    if (wr == 1) PG8_BAR;
    PG8_WAIT_V(4); PG8_BAR;
    PG8_STAGE(PG8_SB(1, 0), cB + kstep, voffB); PG8_STAGE(PG8_SA(1, 0), cA + kstep, voffA); PG8_STAGE(PG8_SB(1, 1), cB + hstepB + kstep, voffB);
    PG8_WAIT_V(6); PG8_BAR;
    for (;;) {
        const bool has_next = unit_next<nM, nN>(ui + 1, G, c, nxt);
        const char* nA = cA; const char* nB = cB; if (has_next) UNIT_PTRS(nxt, nA, nB);
        const char* nX = has_next ? UNIT_X(nxt) : cX;
        for (int t = 0; t < nt; t += 2) {
            const bool last = (t == nt - 2);
            const bool xs1 = (MODE == 1) && (t >= 16), xs2 = (MODE == 1) && (t + 2 >= 16);
            const char* a1 = (xs1 ? cX : cA) + (size_t)(t + 1) * kstep;
            const char* a2 = last ? nA : (xs2 ? cX : cA) + (size_t)(t + 2) * kstep; const char* b2 = last ? nB : (xs2 ? idm : cB) + (size_t)(t + 2) * kstep;
            const char* a3 = a2 + kstep; const char* b3 = b2 + kstep;
            PG8_LDB(B0, 0, 0); PG8_SCHED; PG8_LDA(At, 0, 0); PG8_STAGE(PG8_SA(1, 1), a1 + hstepA, voffA);
            PG8_WAIT_L(8); PG8_BAR; PG8_WAIT_L(0); PG8_MMA(0, 0, At, B0); PG8_BAR; PG8_SCHED;
            PG8_LDB(B1, 0, 1); PG8_STAGE(PG8_SB(0, 0), b2, voffB);
            PG8_BAR; PG8_WAIT_L(0); PG8_MMA(0, 1, At, B1); PG8_BAR;
            PG8_LDA(At, 0, 1); PG8_STAGE(PG8_SA(0, 0), a2, voffA);
            PG8_BAR; PG8_WAIT_L(0); PG8_MMA(1, 0, At, B0); PG8_BAR; PG8_SCHED;
            PG8_STAGE(PG8_SB(0, 1), b2 + hstepB, voffB);
            PG8_WAIT_V(6); PG8_BAR; PG8_MMA(1, 1, At, B1); PG8_BAR;
            PG8_LDB(B0, 1, 0); PG8_SCHED; PG8_LDA(At, 1, 0); PG8_STAGE(PG8_SA(0, 1), a2 + hstepA, voffA);
            PG8_WAIT_L(8); PG8_BAR; PG8_WAIT_L(0); PG8_MMA(0, 0, At, B0); PG8_BAR; PG8_SCHED;
            PG8_LDB(B1, 1, 1); PG8_STAGE(PG8_SB(1, 0), b3, voffB);
            PG8_BAR; PG8_WAIT_L(0); PG8_MMA(0, 1, At, B1); PG8_BAR;
            PG8_LDA(At, 1, 1); PG8_STAGE(PG8_SA(1, 0), a3, voffA);
            PG8_BAR; PG8_WAIT_L(0); PG8_MMA(1, 0, At, B0); PG8_BAR; PG8_SCHED;
            PG8_STAGE(PG8_SB(1, 1), b3 + hstepB, voffB);
            PG8_WAIT_V(6); PG8_BAR; PG8_MMA(1, 1, At, B1); PG8_BAR;
        }
        if (MODE == 0) epi_gemm1(acc, cur, wr, wc, fr, fq, p); else epi_gemm2(acc, cur, wr, wc, fr, fq, p);
        if (!has_next) break;
        acc_init<MODE>(acc, nxt, wr, wc, fr, fq, p);
        cur = nxt; cA = nA; cB = nB; cX = nX; ++ui;
    }
    PG8_WAIT_V(0);
    if (wr == 0) PG8_BAR;
    PG8_BAR;
#undef PG8_SA
#undef PG8_SB
#undef PG8_STAGE
#undef PG8_LDA
#undef PG8_LDB
#undef PG8_MMA
#undef UNIT_PTRS
#undef UNIT_X
}

constexpr int PSTR = 1040;
constexpr int RPB_OFF = 147456;
#define SCHED_FENCE __builtin_amdgcn_sched_barrier(0)
__device__ __forceinline__ void acc8(float (&a)[8], u32x4 w, const float sgn) { asm("" : "+v"(w));
    a[0] += sgn * bf_lo(w.x); a[1] += sgn * bf_hi(w.x); a[2] += sgn * bf_lo(w.y); a[3] += sgn * bf_hi(w.y);
    a[4] += sgn * bf_lo(w.z); a[5] += sgn * bf_hi(w.z); a[6] += sgn * bf_lo(w.w); a[7] += sgn * bf_hi(w.w);
}
template <int A> __device__ __forceinline__ void pool_a(LAS unsigned char* ldsdst, const bf16_t* Ub, const int pos0, const int S) {
    constexpr int NR = 8 + 2 * A - 1;
    u32x4 rows[NR];
#pragma unroll
    for (int j = 0; j < NR; ++j) { const int pos = pos0 - A + j; const int pc = pos < 0 ? 0 : (pos >= S ? S - 1 : pos); rows[j] = *(const u32x4*)(Ub + (size_t)pc * 512); }
    SCHED_FENCE;
#pragma unroll
    for (int j = 0; j < NR; ++j) { const int pos = pos0 - A + j; if (pos < 0 || pos >= S) rows[j] = (u32x4){0u, 0u, 0u, 0u}; }
    float acc[8];
#pragma unroll
    for (int j = 0; j < 8; ++j) acc[j] = 0.f;
#pragma unroll
    for (int j = 0; j < 2 * A; ++j) acc8(acc, rows[j], 1.0f);
#pragma unroll
    for (int t = 0; t < 8; ++t) {
        const int pos = pos0 + t; const int hi = (pos + A < S) ? pos + A : S, lo = (pos - A > 0) ? pos - A : 0;
        const float inv = 1.0f / (float)(hi - lo);
        const u32x4 cw = rows[A + t];
        float o[8];
        o[0] = acc[0] * inv - bf_lo(cw.x); o[1] = acc[1] * inv - bf_hi(cw.x); o[2] = acc[2] * inv - bf_lo(cw.y); o[3] = acc[3] * inv - bf_hi(cw.y);
        o[4] = acc[4] * inv - bf_lo(cw.z); o[5] = acc[5] * inv - bf_hi(cw.z); o[6] = acc[6] * inv - bf_lo(cw.w); o[7] = acc[7] * inv - bf_hi(cw.w);
        u32x4 w; w.x = cvt_pk_bf16(o[0], o[1]); w.y = cvt_pk_bf16(o[2], o[3]); w.z = cvt_pk_bf16(o[4], o[5]); w.w = cvt_pk_bf16(o[6], o[7]);
        *(LAS u32x4*)(ldsdst + t * PSTR) = w;
        if (t < 7) { acc8(acc, rows[2 * A + t], 1.0f); acc8(acc, rows[t], -1.0f); }
    }
}
__device__ __forceinline__ void mixer_phase(LAS unsigned char* lds, const Params& p, const int G, const int c) {
    const int tid = threadIdx.x, lane = tid & 63, wid = __builtin_amdgcn_readfirstlane(tid >> 6), fr = lane & 15, fq = lane >> 4;
    const bf16_t* aU = (const bf16_t*)(p.ws + WS_ACT); const bf16_t* aGP = aU + ACT_STRIDE; const bf16_t* aQ = aU + 2 * ACT_STRIDE; const bf16_t* aK = aU + 3 * ACT_STRIDE; const bf16_t* aGA = aU + 4 * ACT_STRIDE;
    const bf16_t* VT = (const bf16_t*)(p.ws + WS_VT); const bf16_t* WpT = (const bf16_t*)(p.ws + WS_WP);
    bf16_t* MIX = (bf16_t*)(p.ws + WS_MIX); const float* rsb = (const float*)(p.ws + WS_RS);
    LAS float* rpbs = (LAS float*)(lds + RPB_OFF);
    for (int i = tid; i < 8 * 465; i += 512) rpbs[i] = p.rpb[i];
    __syncthreads();
    for (int it = 0;; ++it) {
        const int L = it * G + c; if (L >= 1280) break;
        const int gr = (L & 7) * 160 + (L >> 3);
        int R, r; if (gr < 1024) { R = 64; r = gr & 63; } else { R = 128; r = (gr - 1024) & 127; }
        const int gr0 = gr - r; const int S = R * 64;
        u32x2 gw[4][4]; float rsm[4];
        {
            const int g = wid >> 1, dh = wid & 1;
            const bf16_t* gb = aGP + ((size_t)gr * 64 + fr) * 512 + 128 * g + 64 * dh + 4 * fq;
#pragma unroll
            for (int mt = 0; mt < 4; ++mt)
#pragma unroll
                for (int nt = 0; nt < 4; ++nt) gw[mt][nt] = *(const u32x2*)(gb + (size_t)mt * 16 * 512 + 16 * nt);
#pragma unroll
            for (int mt = 0; mt < 4; ++mt) rsm[mt] = rsb[(size_t)gr * 64 + 16 * mt + fr];
        }
        SCHED_FENCE;
        {
            const int g = wid >> 1, th = wid & 1;
            const int c0 = 128 * g + 8 * fr, tl0 = 32 * th + 8 * fq, pos0 = r * 64 + tl0;
            const bf16_t* Ub = aU + (size_t)gr0 * 64 * 512 + c0;
            LAS unsigned char* dst = lds + (it & 1) * (64 * PSTR) + tl0 * PSTR + c0 * 2;
            if (g == 0) pool_a<1>(dst, Ub, pos0, S); else if (g == 1) pool_a<2>(dst, Ub, pos0, S); else if (g == 2) pool_a<4>(dst, Ub, pos0, S); else pool_a<8>(dst, Ub, pos0, S);
        }
        {
            const int g = wid >> 1, dh = wid & 1;
            bf16x8 bfr[4][4]; f32x4 psv[4];
            const bf16_t* wb = WpT + (size_t)(g * 128 + 64 * dh + fr) * 128 + 8 * fq;
#pragma unroll
            for (int nt = 0; nt < 4; ++nt)
#pragma unroll
                for (int ks = 0; ks < 4; ++ks) bfr[nt][ks] = *(const bf16x8*)(wb + nt * 16 * 128 + 32 * ks);
#pragma unroll
            for (int nt = 0; nt < 4; ++nt) psv[nt] = *(const f32x4*)(p.pool_scale + 128 * g + 64 * dh + 16 * nt + 4 * fq);
            SCHED_FENCE;
            __syncthreads();
            f32x4 acc[4][4];
#pragma unroll
            for (int mt = 0; mt < 4; ++mt)
#pragma unroll
                for (int nt = 0; nt < 4; ++nt) acc[mt][nt] = (f32x4){0.f, 0.f, 0.f, 0.f};
#pragma unroll
            for (int ks = 0; ks < 4; ++ks) {
                bf16x8 af[4];
#pragma unroll
                for (int mt = 0; mt < 4; ++mt) af[mt] = *(const LAS bf16x8*)(lds + (it & 1) * (64 * PSTR) + (16 * mt + fr) * PSTR + (128 * g + 32 * ks + 8 * fq) * 2);
#pragma unroll
                for (int mt = 0; mt < 4; ++mt)
#pragma unroll
                    for (int nt = 0; nt < 4; ++nt) acc[mt][nt] = __builtin_amdgcn_mfma_f32_16x16x32_bf16(bfr[nt][ks], af[mt], acc[mt][nt], 0, 0, 0);
            }
            bf16_t* mb = MIX + ((size_t)gr * 64 + fr) * 1024 + 128 * g + 64 * dh + 4 * fq;
#pragma unroll
            for (int mt = 0; mt < 4; ++mt)
#pragma unroll
                for (int nt = 0; nt < 4; ++nt) {
                    const f32x4 a4 = acc[mt][nt] * rsm[mt]; const u32x2 gg = gw[mt][nt];
                    u32x2 w; w.x = cvt_pk_bf16(a4[0] * psv[nt][0] * bf_lo(gg.x), a4[1] * psv[nt][1] * bf_hi(gg.x)); w.y = cvt_pk_bf16(a4[2] * psv[nt][2] * bf_lo(gg.y), a4[3] * psv[nt][3] * bf_hi(gg.y));
                    *(u32x2*)(mb + (size_t)mt * 16 * 1024 + 16 * nt) = w;
                }
        }
    }
    __syncthreads();
}
constexpr int VREG = 73728;
#define A_BAR() do { SCHED_FENCE; asm volatile("s_waitcnt lgkmcnt(0)" ::: "memory"); __builtin_amdgcn_s_barrier(); SCHED_FENCE; } while (0)
__device__ __forceinline__ void gload16_asm(bf16x8& v, const void* ptr) { asm volatile("global_load_dwordx4 %0, %1, off" : "=v"(v) : "v"(ptr) : "memory"); }
__device__ __forceinline__ void gload4_asm(float& v, const void* ptr) { asm volatile("global_load_dword %0, %1, off" : "=v"(v) : "v"(ptr) : "memory"); }
__device__ __forceinline__ void gload8_asm(u32x2& v, const void* ptr) { asm volatile("global_load_dwordx2 %0, %1, off" : "=v"(v) : "v"(ptr) : "memory"); }
struct AUnit { int gr0, R, r0, h, gA, win; };
__device__ __forceinline__ int win_start(int r, int R) { int s = r - 4; s = s < 0 ? 0 : s; return s > R - 8 ? R - 8 : s; }
__device__ __forceinline__ void attn_decode(int L, int G, AUnit& u) {
    int pp;
    if (G == 256) { const int it = L >> 8, c = L & 255, xcd = c & 7, j = c >> 3; u.h = j & 7; pp = 80 * xcd + 20 * (j >> 3) + it; }
    else { const int xcd = L & 7, q = L >> 3; pp = 80 * xcd + (q >> 3); u.h = q & 7; }
    u.gA = 2 * pp;
    if (u.gA < 1024) { u.R = 64; u.r0 = u.gA & 63; } else { u.R = 128; u.r0 = (u.gA - 1024) & 127; }
    u.gr0 = u.gA - u.r0; u.win = win_start(u.r0, u.R);
}
__device__ __forceinline__ void stage_K(LAS unsigned char* lds, const bf16_t* aK, const AUnit& u, int wid, int lane, int pa) {
    const int rsU = u.win; const int col = 8 * wid + (lane >> 3); const int ch = (lane & 7) ^ ((col >> 1) & 7);
    const bf16_t* src = aK + (size_t)col * 512 + u.h * 64 + ch * 8;
#pragma unroll
    for (int m = 0; m < 9; ++m) { int rw = rsU + m; rw = rw > u.R - 1 ? u.R - 1 : rw;
        if (rw < pa || rw > pa + 8) __builtin_amdgcn_global_load_lds((const unsigned*)(src + (size_t)(u.gr0 + rw) * 64 * 512), (LAS unsigned*)(lds + (wid + 8 * (rw % 9)) * 1024), 16, 0, 0); }
}
__device__ __forceinline__ void stage_V(LAS unsigned char* lds, const bf16_t* VT, const AUnit& u, int wid, int lane, int pa) {
    const int rsU = u.win; const int d = 8 * wid + (lane >> 3); const int ch = (lane & 7) ^ ((d >> 1) & 7);
    const bf16_t* src = VT + (size_t)u.h * 4096 + d * 64 + ch * 8;
#pragma unroll
    for (int m = 0; m < 9; ++m) { int rw = rsU + m; rw = rw > u.R - 1 ? u.R - 1 : rw;
        if (rw < pa || rw > pa + 8) __builtin_amdgcn_global_load_lds((const unsigned*)(src + (size_t)(u.gr0 + rw) * 8 * 4096), (LAS unsigned*)(lds + VREG + (wid + 8 * (rw % 9)) * 1024), 16, 0, 0); }
}
__device__ __forceinline__ void attn_phase(LAS unsigned char* lds, const Params& p, const int G, const int c) {
    const int tid = threadIdx.x, lane = tid & 63, wid = __builtin_amdgcn_readfirstlane(tid >> 6), fr = lane & 15, fq = lane >> 4;
    const bf16_t* aU = (const bf16_t*)(p.ws + WS_ACT); const bf16_t* aQ = aU + 2 * ACT_STRIDE; const bf16_t* aK = aU + 3 * ACT_STRIDE; const bf16_t* aGA = aU + 4 * ACT_STRIDE;
    const bf16_t* VT = (const bf16_t*)(p.ws + WS_VT);
    bf16_t* MIX = (bf16_t*)(p.ws + WS_MIX); const float* rsb = (const float*)(p.ws + WS_RS);
    const LAS float* rpbs = (const LAS float*)(lds + RPB_OFF);
    const int sel = wid >> 2, qb = wid & 3;
    const int ws_ = (qb == 0) ? 0 : (qb == 1) ? 8 : (qb == 2) ? 24 : 32;
    int kofs[2][2], vofs[4];
#pragma unroll
    for (int t = 0; t < 2; ++t) { const int kc = ws_ + 8 * (fr >> 2) + 4 * t + (fr & 3); const int sw = (kc >> 1) & 7; kofs[t][0] = kc * 128 + ((fq ^ sw) << 4); kofs[t][1] = kc * 128 + (((fq | 4) ^ sw) << 4); }
#pragma unroll
    for (int dt = 0; dt < 4; ++dt) { const int d = 16 * dt + fr; vofs[dt] = VREG + d * 128 + ((((ws_ >> 3) + fq) ^ ((d >> 1) & 7)) << 4); }
    const int cq = 16 * qb + fr; int cs = cq - 8; cs = cs < 0 ? 0 : cs; cs = cs > 48 ? 48 : cs;
    int L = c; if (L >= 5120) return;
    if (wid >= 4) __builtin_amdgcn_s_setprio(1);
    AUnit cur, nxt; attn_decode(L, G, cur);
    stage_K(lds, aK, cur, wid, lane, -100);
    int pgr0 = -1, pwin = 0;
    size_t qtok = (size_t)(cur.gA + sel) * 64 + 16 * qb + fr;
    bf16x8 qf0, qf1; u32x2 gw[4];
    SCHED_FENCE;
    gload16_asm(qf0, aQ + qtok * 512 + cur.h * 64 + 8 * fq); gload16_asm(qf1, aQ + qtok * 512 + cur.h * 64 + 32 + 8 * fq);
#pragma unroll
    for (int dt = 0; dt < 4; ++dt) gload8_asm(gw[dt], aGA + qtok * 512 + cur.h * 64 + 16 * dt + 4 * fq);
    float rsq; gload4_asm(rsq, rsb + qtok);
    SCHED_FENCE;
    SCHED_FENCE; asm volatile("s_waitcnt vmcnt(0)" ::: "memory"); SCHED_FENCE;
    for (;;) {
        const int r = cur.r0 + sel; const int rs0 = win_start(r, cur.R); const int sb = rs0 % 9;
        const LAS float* rb = rpbs + cur.h * 465 + (rs0 - r + 7) * 31;
        const int h = cur.h;
        SCHED_FENCE; asm volatile("s_waitcnt vmcnt(4) lgkmcnt(0)" ::: "memory"); __builtin_amdgcn_s_barrier(); SCHED_FENCE;
        asm volatile("" : "+v"(qf0), "+v"(qf1)); SCHED_FENCE;
        stage_V(lds, VT, cur, wid, lane, (pgr0 == cur.gr0) ? pwin : -100);
        pgr0 = cur.gr0; pwin = cur.win;
        SCHED_FENCE;
        const int Ln = L + G; const bool has_next = Ln < 5120;
        nxt = cur; if (has_next) attn_decode(Ln, G, nxt);
        const size_t qtok_n = (size_t)(nxt.gA + sel) * 64 + 16 * qb + fr;
        bf16x8 qn0, qn1; u32x2 gn[4];
        gload16_asm(qn0, aQ + qtok_n * 512 + nxt.h * 64 + 8 * fq); gload16_asm(qn1, aQ + qtok_n * 512 + nxt.h * 64 + 32 + 8 * fq);
#pragma unroll
        for (int dt = 0; dt < 4; ++dt) gload8_asm(gn[dt], aGA + qtok_n * 512 + nxt.h * 64 + 16 * dt + 4 * fq);
        float rsn; gload4_asm(rsn, rsb + qtok_n);
        SCHED_FENCE;
        f32x4 s[8][2];
        {
            const LAS unsigned char* kb = lds;
#pragma unroll
            for (int i = 0; i < 8; ++i)
#pragma unroll
                for (int t = 0; t < 2; ++t) {
                    const int so = ((sb + i >= 9) ? sb + i - 9 : sb + i) * 8192;
                    const bf16x8 k0 = *(const LAS bf16x8*)(kb + kofs[t][0] + so), k1 = *(const LAS bf16x8*)(kb + kofs[t][1] + so);
                    f32x4 z = (f32x4){0.f, 0.f, 0.f, 0.f};
                    z = __builtin_amdgcn_mfma_f32_16x16x32_bf16(k0, qf0, z, 0, 0, 0);
                    z = __builtin_amdgcn_mfma_f32_16x16x32_bf16(k1, qf1, z, 0, 0, 0);
                    s[i][t] = z;
                }
        }
        typedef float f32x2 __attribute__((ext_vector_type(2)));
        f32x2 sv[8][2][2];
        float mx = -1e30f;
#pragma unroll
        for (int t = 0; t < 2; ++t)
#pragma unroll
            for (int jp = 0; jp < 2; ++jp) {
                f32x2 mk1, mk2; int bi2[2];
#pragma unroll
                for (int e = 0; e < 2; ++e) { const int j = 2 * jp + e; const int kc = ws_ + 8 * fq + 4 * t + j; const bool valid = (kc >= cs) && (kc < cs + 16);
                    int bi = kc - cq + 15; bi = bi < 0 ? 0 : bi; bi = bi > 30 ? 30 : bi; bi2[e] = bi; mk1[e] = valid ? 1.0f : 0.0f; mk2[e] = valid ? 0.0f : -1e30f; }
#pragma unroll
                for (int i = 0; i < 8; ++i) { f32x2 bb; bb.x = rb[i * 31 + bi2[0]]; bb.y = rb[i * 31 + bi2[1]];
                    f32x2 x; x.x = s[i][t][2 * jp]; x.y = s[i][t][2 * jp + 1];
                    const f32x2 v = (x + bb) * mk1 + mk2; sv[i][t][jp] = v; mx = fmaxf(mx, fmaxf(v.x, v.y)); }
            }
        mx = xmax4(mx);
        const float mxl = mx * 1.44269504f;
        const f32x2 c2 = (f32x2){1.44269504f, 1.44269504f}, m2 = (f32x2){-mxl, -mxl};
        f32x2 sum2 = (f32x2){0.f, 0.f};
#pragma unroll
        for (int i = 0; i < 8; ++i)
#pragma unroll
            for (int t = 0; t < 2; ++t)
#pragma unroll
                for (int jp = 0; jp < 2; ++jp) { const f32x2 a2 = sv[i][t][jp] * c2 + m2; f32x2 e; e.x = __builtin_amdgcn_exp2f(a2.x); e.y = __builtin_amdgcn_exp2f(a2.y);
                    s[i][t][2 * jp] = e.x; s[i][t][2 * jp + 1] = e.y; sum2 += e; }
        float sum = sum2.x + sum2.y;
        sum = xsum4(sum);
        const float inv0 = 1.0f / sum;
        bf16x8 pf[8];
#pragma unroll
        for (int i = 0; i < 8; ++i) {
            u32x4 pw; pw.x = cvt_pk_bf16(s[i][0][0], s[i][0][1]); pw.y = cvt_pk_bf16(s[i][0][2], s[i][0][3]);
            pw.z = cvt_pk_bf16(s[i][1][0], s[i][1][1]); pw.w = cvt_pk_bf16(s[i][1][2], s[i][1][3]);
            pf[i] = __builtin_bit_cast(bf16x8, pw);
        }
        SCHED_FENCE; asm volatile("s_waitcnt vmcnt(0) lgkmcnt(0)" ::: "memory"); __builtin_amdgcn_s_barrier(); SCHED_FENCE;
        stage_K(lds, aK, nxt, wid, lane, (nxt.gr0 == cur.gr0) ? cur.win : -100);
        SCHED_FENCE;
        asm volatile("" : "+v"(qn0), "+v"(qn1), "+v"(gn[0]), "+v"(gn[1]), "+v"(gn[2]), "+v"(gn[3]), "+v"(gw[0]), "+v"(gw[1]), "+v"(gw[2]), "+v"(gw[3]), "+v"(rsn), "+v"(rsq)); SCHED_FENCE;
        f32x4 o[4];
#pragma unroll
        for (int dt = 0; dt < 4; ++dt) o[dt] = (f32x4){0.f, 0.f, 0.f, 0.f};
        {
            const LAS unsigned char* vb = lds;
#pragma unroll
            for (int i = 0; i < 8; ++i)
#pragma unroll
                for (int dt = 0; dt < 4; ++dt) { const int so = ((sb + i >= 9) ? sb + i - 9 : sb + i) * 8192;
                    const bf16x8 vf = *(const LAS bf16x8*)(vb + vofs[dt] + so); o[dt] = __builtin_amdgcn_mfma_f32_16x16x32_bf16(vf, pf[i], o[dt], 0, 0, 0); }
        }
#pragma unroll
        for (int dt = 0; dt < 4; ++dt) {
            const int chn = h * 64 + 16 * dt + 4 * fq;
            const float inv = inv0 * rsq;
            u32x2 w; w.x = cvt_pk_bf16(o[dt][0] * inv * bf_lo(gw[dt].x), o[dt][1] * inv * bf_hi(gw[dt].x)); w.y = cvt_pk_bf16(o[dt][2] * inv * bf_lo(gw[dt].y), o[dt][3] * inv * bf_hi(gw[dt].y));
            *(u32x2*)(MIX + qtok * 1024 + 512 + chn) = w;
        }
        if (!has_next) break;
        cur = nxt; L = Ln; qtok = qtok_n; qf0 = qn0; qf1 = qn1; rsq = rsn;
#pragma unroll
        for (int dt = 0; dt < 4; ++dt) gw[dt] = gn[dt];
    }
    asm volatile("s_waitcnt vmcnt(0)" ::: "memory"); __builtin_amdgcn_s_barrier();
    __builtin_amdgcn_s_setprio(0);
}


}
__global__ void __launch_bounds__(512, 2) fwd_kernel(Params p) {
    extern __shared__ __attribute__((aligned(16))) unsigned char shm[];
    LAS unsigned char* lds = (LAS unsigned char*)shm;
    const int G = gridDim.x, c = blockIdx.x;
    cg::grid_group grid = cg::this_grid();
#ifndef REP0
#define REP0 1
#endif
#ifndef REP1
#define REP1 1
#endif
#ifndef REP2
#define REP2 1
#endif
#ifndef REP3
#define REP3 1
#endif
    volatile LAS unsigned* bst = (volatile LAS unsigned*)(lds + 147456 + 8 * 465 * 4);
    if (threadIdx.x < 2) bst[threadIdx.x] = 0u;
    __syncthreads();
    XcdBarrier xbar = xcd_barrier_post((unsigned*)(p.ws + WS_BAR), bst);
#define GRID_SYNC() do { if (p.coop) { if (p.use_cg) grid.sync(); else xcd_barrier(xbar); } } while (0)
    if (p.ph_lo <= 0 && 0 < p.ph_hi) { for (int rep = 0; rep < REP0; ++rep) { prep_phase(p, G); GRID_SYNC(); } }
    if (p.ph_lo <= 1 && 1 < p.ph_hi) { for (int rep = 0; rep < REP1; ++rep) { gemm_phase<0>(lds, p, G, c); GRID_SYNC(); } }
    if (p.ph_lo <= 2 && 2 < p.ph_hi) { for (int rep = 0; rep < REP2; ++rep) { mixer_phase(lds, p, G, c); attn_phase(lds, p, G, c); GRID_SYNC(); } }
    if (p.ph_lo <= 3 && 3 < p.ph_hi) { for (int rep = 0; rep < REP3; ++rep) { gemm_phase<1>(lds, p, G, c); if (REP3 > 1 && p.coop) grid.sync(); } }
}

#ifndef N_LAUNCHES
#define N_LAUNCHES 1
#endif

extern "C" void kernel_launch(void* const* d_in, const int* in_sizes, int n_in, void* d_out, int out_size, void* d_ws, size_t ws_size, hipStream_t stream) {
    static int grid = 0;
    if (grid == 0) {
        if (n_in != 10 || ws_size < WS_END) { fprintf(stderr, "kernel_launch: unexpected inputs (n_in %d, ws %zu < %zu)\n", n_in, ws_size, (size_t)WS_END); grid = -1; return; }
        int dev = 0, cus = 0, per_cu = 0;
        (void)hipGetDevice(&dev); (void)hipDeviceGetAttribute(&cus, hipDeviceAttributeMultiprocessorCount, dev);
        if (hipFuncSetAttribute((const void*)fwd_kernel, hipFuncAttributeMaxDynamicSharedMemorySize, LDS_BYTES) != hipSuccess) { fprintf(stderr, "kernel_launch: hipFuncSetAttribute failed\n"); grid = -1; return; }
        (void)hipOccupancyMaxActiveBlocksPerMultiprocessor(&per_cu, (const void*)fwd_kernel, 512, LDS_BYTES);
        (void)hipGetLastError();
        if (per_cu < 1) per_cu = 1;
        grid = cus;
    }
    if (grid < 0) return;
    Params p{};
    p.xp = (const float*)d_in[0]; p.xs = (const float*)d_in[1]; p.norm_g = (const float*)d_in[2]; p.w_in = (const float*)d_in[3]; p.w_pool = (const float*)d_in[4];
    p.pool_scale = (const float*)d_in[5]; p.qg = (const float*)d_in[6]; p.kg = (const float*)d_in[7]; p.rpb = (const float*)d_in[8]; p.w_out = (const float*)d_in[9];
    p.out = (float*)d_out; p.ws = (unsigned char*)d_ws; p.use_cg = 0;
    (void)hipMemsetAsync((char*)d_ws + WS_BAR, 0, XCD_BAR_WORDS * 4, stream);
#if N_LAUNCHES == 1
    p.ph_lo = 0; p.ph_hi = 4; p.coop = 1;
    void* args[] = {&p};
    hipError_t e = hipLaunchCooperativeKernel((const void*)fwd_kernel, dim3(grid), dim3(512), args, LDS_BYTES, stream);
    if (e != hipSuccess) fprintf(stderr, "cooperative launch failed: %s (grid %d)\n", hipGetErrorString(e), grid);
#else
    for (int ph = 0; ph < 4; ++ph) { p.ph_lo = ph; p.ph_hi = ph + 1; p.coop = 0; hipLaunchKernelGGL(fwd_kernel, dim3(grid), dim3(512), LDS_BYTES, stream, p); }
#endif
}
```

```cpp
#include <hip/hip_runtime.h>
#include <hip/hip_cooperative_groups.h>
#include <cstdio>
namespace cg = cooperative_groups;

#define LAS __attribute__((address_space(3)))
typedef unsigned short bf16_t;
typedef short bf16x8 __attribute__((ext_vector_type(8)));
typedef float f32x4 __attribute__((ext_vector_type(4)));
typedef unsigned u32x4 __attribute__((ext_vector_type(4)));
typedef unsigned u32x2 __attribute__((ext_vector_type(2)));

namespace {
constexpr int NTOK = 81920, NTOK_P = 65536;
constexpr float EPS = 1e-6f;
constexpr int BM = 256, BK = 64, HALF = 128, HTB = HALF * BK * 2, STAGE_BYTES = 8 * HTB;
constexpr int LDS_BYTES = 147456 + 8 * 465 * 4 + 16;
constexpr size_t ACT_STRIDE = (size_t)NTOK * 512;
constexpr size_t WS_XB = 0;
constexpr size_t WS_RS = WS_XB + (size_t)NTOK * 1024 * 2;
constexpr size_t WS_WIN = WS_RS + (size_t)NTOK * 4;
constexpr size_t WS_WOUT = WS_WIN + (size_t)3072 * 1024 * 2;
constexpr size_t WS_WP = WS_WOUT + (size_t)1024 * 1024 * 2;
constexpr size_t WS_ACT = WS_WP + (size_t)4 * 128 * 128 * 2;
constexpr size_t WS_VT = WS_ACT + 5 * ACT_STRIDE * 2;
constexpr size_t WS_MIX = WS_VT + ACT_STRIDE * 2;
constexpr size_t WS_RSI = WS_MIX + (size_t)NTOK * 1024 * 2;
constexpr size_t WS_ID = WS_RSI + (size_t)NTOK * 4;
constexpr size_t WS_BAR = WS_ID + (size_t)256 * 1024 * 2;
constexpr size_t WS_END = WS_BAR + 16384;

struct Params {
    const float* xp; const float* xs; const float* norm_g; const float* w_in; const float* w_pool; const float* pool_scale;
    const float* qg; const float* kg; const float* rpb; const float* w_out; float* out; unsigned char* ws;
    int ph_lo, ph_hi, coop, use_cg;
};
#define XB_TMO      128
#define XB_XCNT(j)  (256  + 64 * (j))
#define XB_XSUB(j)  (1280 + 64 * (j))
#define XB_XGEN(j)  (2304 + 64 * (j))
#define XB_TOP      3328
#define XB_TOPGEN   3392
#define XCD_BAR_WORDS 3456
#define XB_SPIN_CAP (1u << 22)
__device__ __forceinline__ unsigned xb_ld(unsigned* p)              { return __hip_atomic_load(p, __ATOMIC_RELAXED, __HIP_MEMORY_SCOPE_AGENT); }
__device__ __forceinline__ unsigned xb_add(unsigned* p, unsigned v) { return __hip_atomic_fetch_add(p, v, __ATOMIC_RELAXED, __HIP_MEMORY_SCOPE_AGENT); }
__device__ __forceinline__ unsigned xb_xcc_id() { return (unsigned)__builtin_amdgcn_s_getreg((3 << 11) | 20) & 0xFu; }
#define XB_SPIN(cond, bar) do { unsigned _sp = 0; while (cond) { __builtin_amdgcn_s_sleep(1); \
    if ((++_sp & 255u) == 0u) { if (xb_ld(&(bar)[XB_TMO])) break; if (_sp > XB_SPIN_CAP) { atomicAdd(&(bar)[XB_TMO], 1u); break; } } } } while (0)
struct XcdBarrier { unsigned* bar; unsigned x; volatile LAS unsigned* st; };
__device__ __forceinline__ XcdBarrier xcd_barrier_post(unsigned* bar, volatile LAS unsigned* st) {
    XcdBarrier b; b.bar = bar; b.x = xb_xcc_id(); b.st = st;
    if (threadIdx.x == 0) (void)xb_add(&bar[XB_XCNT(b.x)], 1u);
    return b;
}
__device__ __forceinline__ void xcd_barrier_complete(unsigned* bar, unsigned x, unsigned& nloc, unsigned& nx) {
    const unsigned G = gridDim.x * gridDim.y * gridDim.z;
    unsigned sum, cnt, mine, sp = 0u;
    for (;;) {
        sum = 0u; cnt = 0u; mine = 0u;
#pragma unroll
        for (unsigned j = 0; j < 16; ++j) { const unsigned c = xb_ld(&bar[XB_XCNT(j)]); sum += c; cnt += (c > 0u) ? 1u : 0u; mine = (j == x) ? c : mine; }
        if (sum == G) break;
        __builtin_amdgcn_s_sleep(1);
        if ((++sp & 255u) == 0u) { if (xb_ld(&bar[XB_TMO])) break; if (sp > XB_SPIN_CAP) { atomicAdd(&bar[XB_TMO], 1u); break; } }
    }
    nloc = mine > 0u ? mine : 1u; nx = cnt > 0u ? cnt : 1u;
}
__device__ __forceinline__ void xcd_barrier(const XcdBarrier& b) {
    asm volatile("s_waitcnt vmcnt(0) lgkmcnt(0)" ::: "memory");
    __syncthreads();
    if (threadIdx.x == 0) {
        unsigned* bar = b.bar;
        __builtin_amdgcn_s_waitcnt(0);
        unsigned nloc = b.st[0], nx = b.st[1];
        if (nloc == 0u) { xcd_barrier_complete(bar, b.x, nloc, nx); b.st[0] = nloc; b.st[1] = nx; }
        const unsigned old = xb_add(&bar[XB_XSUB(b.x)], 1u);
        const unsigned gen = old / nloc;
        if (old + 1u == (gen + 1u) * nloc) {
            __builtin_amdgcn_fence(__ATOMIC_RELEASE, "agent");
            asm volatile("s_waitcnt vmcnt(0)" ::: "memory");
            const unsigned og = xb_add(&bar[XB_TOP], 1u);
            const unsigned tg = og / nx;
            if (og + 1u == (tg + 1u) * nx) xb_add(&bar[XB_TOPGEN], 1u);
            else XB_SPIN(xb_ld(&bar[XB_TOPGEN]) == tg, bar);
            __builtin_amdgcn_fence(__ATOMIC_ACQUIRE, "agent");
            xb_add(&bar[XB_XGEN(b.x)], 1u);
            asm volatile("s_waitcnt vmcnt(0)" ::: "memory");
        } else {
            XB_SPIN(xb_ld(&bar[XB_XGEN(b.x)]) == gen, bar);
            __builtin_amdgcn_fence(__ATOMIC_ACQUIRE, "agent");
            asm volatile("s_waitcnt vmcnt(0)" ::: "memory");
        }
    }
    __syncthreads();
}

__device__ __forceinline__ unsigned cvt_pk_bf16(float lo, float hi) { unsigned r; asm("v_cvt_pk_bf16_f32 %0, %1, %2" : "=v"(r) : "v"(lo), "v"(hi)); return r; }
__device__ __forceinline__ float bf_lo(unsigned w) { return __uint_as_float(w << 16); }
__device__ __forceinline__ float bf_hi(unsigned w) { return __uint_as_float(w & 0xffff0000u); }
typedef unsigned xr_u2 __attribute__((ext_vector_type(2)));
__device__ __forceinline__ float xsum4(float x) {
    xr_u2 r = __builtin_amdgcn_permlane32_swap(__float_as_uint(x), __float_as_uint(x), false, false); const float s = __uint_as_float(r.x) + __uint_as_float(r.y);
    xr_u2 q = __builtin_amdgcn_permlane16_swap(__float_as_uint(s), __float_as_uint(s), false, false); return __uint_as_float(q.x) + __uint_as_float(q.y);
}
__device__ __forceinline__ float xmax4(float x) {
    xr_u2 r = __builtin_amdgcn_permlane32_swap(__float_as_uint(x), __float_as_uint(x), false, false); const float s = fmaxf(__uint_as_float(r.x), __uint_as_float(r.y));
    xr_u2 q = __builtin_amdgcn_permlane16_swap(__float_as_uint(s), __float_as_uint(s), false, false); return fmaxf(__uint_as_float(q.x), __uint_as_float(q.y));
}
__device__ __forceinline__ float silu_f(float v) { return v * __builtin_amdgcn_rcpf(1.0f + __expf(-v)); }

__device__ __forceinline__ int lds_byte(int r, int c) { const int st = (r >> 4) * 2 + (c >> 5), rr = r & 15, cc = c & 31, ob = rr * 64 + cc * 2; return st * 1024 + (ob ^ (((ob >> 9) & 1) << 5)); }
__device__ __forceinline__ void stage_rc(int b, int& R, int& C) { const int st = b / 1024, sb = b % 1024, swz = sb ^ (((sb >> 9) & 1) << 5); R = (st >> 1) * 16 + swz / 64; C = (st & 1) * 32 + (swz % 64) / 2; }
__device__ __forceinline__ int perm32(int rho) { const int n = rho >> 4, i = rho & 15; return 8 * (i >> 2) + 4 * n + (i & 3); }

#ifndef WGM1
#define WGM1 16
#endif
struct Unit { int pm, pn; };
template <int nM, int nN> __device__ __forceinline__ bool unit_next(int i, int G, int c, Unit& u) {
    constexpr int nwg = nM * nN; const long L = (long)i * G + c; if (L >= nwg) return false;
    int wgid = (int)L; { constexpr int q = nwg / 8, r = nwg % 8; const int xcd = wgid % 8, off = wgid / 8; wgid = (xcd < r ? xcd * (q + 1) : r * (q + 1) + (xcd - r) * q) + off; }
    constexpr int WGM = (nN == 12) ? WGM1 : 8;
    constexpr int nig = WGM * nN; const int gid = wgid / nig, fm = gid * WGM, gsz = (nM - fm) < WGM ? (nM - fm) : WGM;
    u.pm = fm + ((wgid % nig) % gsz); u.pn = (wgid % nig) / gsz; return true;
}

__device__ __forceinline__ void prep_phase(const Params& p, int G) {
    const int tid = threadIdx.x, lane = tid & 63, wid = tid >> 6;
    bf16_t* xb = (bf16_t*)(p.ws + WS_XB); float* rsb = (float*)(p.ws + WS_RS); float* rsib = (float*)(p.ws + WS_RSI);
    const int nw = G * 8;
#define PREP_LOAD(dst, row) do { const float* _xr = ((row) < NTOK_P) ? p.xp + (size_t)(row) * 1024 : p.xs + (size_t)((row) - NTOK_P) * 1024; \
        dst[0] = __builtin_nontemporal_load((const f32x4*)(_xr + lane * 8)); dst[1] = __builtin_nontemporal_load((const f32x4*)(_xr + lane * 8 + 4)); \
        dst[2] = __builtin_nontemporal_load((const f32x4*)(_xr + 512 + lane * 8)); dst[3] = __builtin_nontemporal_load((const f32x4*)(_xr + 512 + lane * 8 + 4)); } while (0)
#define PREP_DO(v, row) do { float ss = 0.f; \
        _Pragma("unroll") for (int k = 0; k < 4; ++k) _Pragma("unroll") for (int j = 0; j < 4; ++j) ss += v[k][j] * v[k][j]; \
        _Pragma("unroll") for (int o = 32; o >= 1; o >>= 1) ss += __shfl_xor(ss, o); \
        const float rsc = rsqrtf(ss * (1.0f / 1024.0f) + EPS); u32x4 w0, w1; if (lane == 0) { rsb[row] = rsc; rsib[row] = sqrtf(ss * (1.0f / 1024.0f) + EPS); } \
        w0.x = cvt_pk_bf16(v[0][0] * rsc, v[0][1] * rsc); w0.y = cvt_pk_bf16(v[0][2] * rsc, v[0][3] * rsc); w0.z = cvt_pk_bf16(v[1][0] * rsc, v[1][1] * rsc); w0.w = cvt_pk_bf16(v[1][2] * rsc, v[1][3] * rsc); \
        w1.x = cvt_pk_bf16(v[2][0] * rsc, v[2][1] * rsc); w1.y = cvt_pk_bf16(v[2][2] * rsc, v[2][3] * rsc); w1.z = cvt_pk_bf16(v[3][0] * rsc, v[3][1] * rsc); w1.w = cvt_pk_bf16(v[3][2] * rsc, v[3][3] * rsc); \
        *(u32x4*)(xb + (size_t)(row) * 1024 + lane * 8) = w0; *(u32x4*)(xb + (size_t)(row) * 1024 + 512 + lane * 8) = w1; } while (0)
    {
        int row = blockIdx.x * 8 + wid;
        f32x4 va[4], vb[4], vc[4];
        if (row < NTOK) PREP_LOAD(va, row);
        if (row + nw < NTOK) PREP_LOAD(vb, row + nw);
        for (; row < NTOK; row += 3 * nw) {
            if (row + 2 * nw < NTOK) PREP_LOAD(vc, row + 2 * nw);
            PREP_DO(va, row);
            if (row + nw < NTOK) { if (row + 3 * nw < NTOK) PREP_LOAD(va, row + 3 * nw); PREP_DO(vb, row + nw); }
            if (row + 2 * nw < NTOK) { if (row + 4 * nw < NTOK) PREP_LOAD(vb, row + 4 * nw); PREP_DO(vc, row + 2 * nw); }
        }
    }
#undef PREP_LOAD
#undef PREP_DO
    const int gt = blockIdx.x * 512 + tid, T = G * 512;
    bf16_t* WinT = (bf16_t*)(p.ws + WS_WIN); bf16_t* WoutT = (bf16_t*)(p.ws + WS_WOUT); bf16_t* WpT = (bf16_t*)(p.ws + WS_WP);
    for (int idx = gt; idx < 3072 * 128; idx += T) {
        const int n = idx % 3072, k8 = idx / 3072; float v[8];
#pragma unroll
        for (int j = 0; j < 8; ++j) v[j] = p.w_in[(size_t)(k8 * 8 + j) * 3072 + n] * p.norm_g[k8 * 8 + j];
        u32x4 w; w.x = cvt_pk_bf16(v[0], v[1]); w.y = cvt_pk_bf16(v[2], v[3]); w.z = cvt_pk_bf16(v[4], v[5]); w.w = cvt_pk_bf16(v[6], v[7]);
        *(u32x4*)(WinT + (size_t)n * 1024 + k8 * 8) = w;
    }
    for (int idx = gt; idx < 1024 * 128; idx += T) {
        const int n = idx % 1024, k8 = idx / 1024; float v[8];
#pragma unroll
        for (int j = 0; j < 8; ++j) v[j] = p.w_out[(size_t)(k8 * 8 + j) * 1024 + n];
        u32x4 w; w.x = cvt_pk_bf16(v[0], v[1]); w.y = cvt_pk_bf16(v[2], v[3]); w.z = cvt_pk_bf16(v[4], v[5]); w.w = cvt_pk_bf16(v[6], v[7]);
        *(u32x4*)(WoutT + (size_t)n * 1024 + k8 * 8) = w;
    }
    for (int idx = gt; idx < 256 * 128; idx += T) {
        const int n = idx >> 7, k8 = idx & 127; u32x4 w = (u32x4){0u, 0u, 0u, 0u};
        if (k8 == (n >> 3)) { const unsigned one = 0x3F80u << (16 * (n & 1)); const int wd = (n & 7) >> 1; w.x = wd == 0 ? one : 0u; w.y = wd == 1 ? one : 0u; w.z = wd == 2 ? one : 0u; w.w = wd == 3 ? one : 0u; }
        *(u32x4*)((bf16_t*)(p.ws + WS_ID) + (size_t)n * 1024 + k8 * 8) = w;
    }
    for (int idx = gt; idx < 4 * 128 * 16; idx += T) {
        const int d = idx % 128, c8 = (idx / 128) % 16, g = idx / 2048; float v[8];
#pragma unroll
        for (int j = 0; j < 8; ++j) v[j] = p.w_pool[(size_t)(g * 128 + c8 * 8 + j) * 128 + d];
        u32x4 w; w.x = cvt_pk_bf16(v[0], v[1]); w.y = cvt_pk_bf16(v[2], v[3]); w.z = cvt_pk_bf16(v[4], v[5]); w.w = cvt_pk_bf16(v[6], v[7]);
        *(u32x4*)(WpT + (size_t)(g * 128 + d) * 128 + c8 * 8) = w;
    }
}

__device__ __forceinline__ void epi_gemm1(const f32x4 (&acc)[2][2][4][2], const Unit& u, int wr, int wc, int fr, int fq, const Params& p) {
    if (u.pn == 8 || u.pn == 9) {
        bf16_t* VT = (bf16_t*)(p.ws + WS_VT);
        const int gr = u.pm * 4 + wc;
#pragma unroll
        for (int ai = 0; ai < 2; ++ai)
#pragma unroll
            for (int m = 0; m < 4; ++m) {
                const int vc = (u.pn - 8) * 256 + ai * 128 + wr * 64 + m * 16 + fr; const int h = vc >> 6, d = vc & 63;
                bf16_t* dst = VT + ((size_t)(gr * 8 + h) * 64 + d) * 64 + fq * 8;
#pragma unroll
                for (int bj = 0; bj < 2; ++bj) { const f32x4 v0 = acc[ai][bj][m][0], v1 = acc[ai][bj][m][1];
                    u32x4 w; w.x = cvt_pk_bf16(v0[0], v0[1]); w.y = cvt_pk_bf16(v0[2], v0[3]); w.z = cvt_pk_bf16(v1[0], v1[1]); w.w = cvt_pk_bf16(v1[2], v1[3]);
                    __builtin_nontemporal_store(w, (u32x4*)(dst + 32 * bj)); }
            }
    } else {
        const int kind = u.pn < 8 ? (u.pn >> 1) : 4;
        bf16_t* base = (bf16_t*)(p.ws + WS_ACT) + (size_t)kind * ACT_STRIDE;
        const int row0 = u.pm * 256 + wr * 64 + fr, col0 = (u.pn & 1) * 256 + wc * 64 + fq * 8;
        f32x4 gv[2][2];
        if (kind == 2 || kind == 3) { const float* g = kind == 2 ? p.qg : p.kg; const float sc = kind == 2 ? 0.125f : 1.0f;
#pragma unroll
            for (int bj = 0; bj < 2; ++bj)
#pragma unroll
                for (int n = 0; n < 2; ++n) gv[bj][n] = *(const f32x4*)(g + 32 * bj + 8 * fq + 4 * n) * sc; }
#pragma unroll
        for (int ai = 0; ai < 2; ++ai)
#pragma unroll
            for (int m = 0; m < 4; ++m) {
                const int row = row0 + ai * 128 + m * 16;
                f32x4 v[2][2];
#pragma unroll
                for (int bj = 0; bj < 2; ++bj)
#pragma unroll
                    for (int n = 0; n < 2; ++n) v[bj][n] = acc[ai][bj][m][n];
                if (kind == 2 || kind == 3) {
                    float ss = 0.f;
#pragma unroll
                    for (int bj = 0; bj < 2; ++bj)
#pragma unroll
                        for (int n = 0; n < 2; ++n) { const f32x4 x = v[bj][n]; ss += (x[0] * x[0] + x[1] * x[1]) + (x[2] * x[2] + x[3] * x[3]); }
                    ss = xsum4(ss);
                    const float sc = rsqrtf(ss * (1.0f / 64.0f) + EPS);
#pragma unroll
                    for (int bj = 0; bj < 2; ++bj)
#pragma unroll
                        for (int n = 0; n < 2; ++n) v[bj][n] = v[bj][n] * gv[bj][n] * sc;
                } else if (kind == 1 || kind == 4) {
#pragma unroll
                    for (int bj = 0; bj < 2; ++bj)
#pragma unroll
                        for (int n = 0; n < 2; ++n)
#pragma unroll
                            for (int j = 0; j < 4; ++j) v[bj][n][j] = silu_f(v[bj][n][j]);
                }
                bf16_t* dst = base + (size_t)row * 512 + col0;
#pragma unroll
                for (int bj = 0; bj < 2; ++bj) { u32x4 w; w.x = cvt_pk_bf16(v[bj][0][0], v[bj][0][1]); w.y = cvt_pk_bf16(v[bj][0][2], v[bj][0][3]); w.z = cvt_pk_bf16(v[bj][1][0], v[bj][1][1]); w.w = cvt_pk_bf16(v[bj][1][2], v[bj][1][3]);
                    __builtin_nontemporal_store(w, (u32x4*)(dst + 32 * bj)); }
            }
    }
}
__device__ __forceinline__ void epi_gemm2(const f32x4 (&acc)[2][2][4][2], const Unit& u, int wr, int wc, int fr, int fq, const Params& p) {
    const int row0 = u.pm * 256 + wr * 64 + fr, col0 = u.pn * 256 + wc * 32 + 4 * fq;
    const float* rsi = (const float*)(p.ws + WS_RSI) + row0; float ri[2][4];
#pragma unroll
    for (int ai = 0; ai < 2; ++ai)
#pragma unroll
        for (int m = 0; m < 4; ++m) ri[ai][m] = rsi[ai * 128 + m * 16];
#pragma unroll
    for (int ai = 0; ai < 2; ++ai)
#pragma unroll
        for (int m = 0; m < 4; ++m) {
            const int row = row0 + ai * 128 + m * 16;
            float* orow = p.out + (size_t)row * 1024 + col0;
#pragma unroll
            for (int bj = 0; bj < 2; ++bj)
#pragma unroll
                for (int n = 0; n < 2; ++n) *(f32x4*)(orow + bj * 128 + n * 16) = acc[ai][bj][m][n] * ri[ai][m];
        }
}

template <int MODE> __device__ __forceinline__ void acc_init(f32x4 (&acc)[2][2][4][2], const Unit& u, int wr, int wc, int fr, int fq, const Params& p) {
    if (MODE == 0) {
#pragma unroll
        for (int a = 0; a < 2; ++a)
#pragma unroll
            for (int b = 0; b < 2; ++b)
#pragma unroll
                for (int m = 0; m < 4; ++m)
#pragma unroll
                    for (int n = 0; n < 2; ++n) acc[a][b][m][n] = (f32x4){0.f, 0.f, 0.f, 0.f};
    } else {
#pragma unroll
        for (int a = 0; a < 2; ++a)
#pragma unroll
            for (int b = 0; b < 2; ++b)
#pragma unroll
                for (int m = 0; m < 4; ++m)
#pragma unroll
                    for (int n = 0; n < 2; ++n) acc[a][b][m][n] = (f32x4){0.f, 0.f, 0.f, 0.f};
    }
}
template <int MODE>
__device__ __forceinline__ void gemm_phase(LAS unsigned char* lds, const Params& p, const int G, const int c) {
    constexpr int K = 1024, nt = (MODE == 0 ? 16 : 20);
    constexpr int nM = NTOK / 256, nN = (MODE == 0 ? 12 : 4);
    const char* Aop = (const char*)(p.ws + (MODE == 0 ? WS_XB : WS_MIX));
    const char* idm = (const char*)(p.ws + WS_ID) - 16 * (size_t)(BK * 2);
    const char* Bop = (const char*)(p.ws + (MODE == 0 ? WS_WIN : WS_WOUT));
    const int tid = threadIdx.x, wid = __builtin_amdgcn_readfirstlane(tid >> 6), lane = tid & 63, wr = wid >> 2, wc = wid & 3, fr = lane & 15, fq = lane >> 4;
    unsigned voffA[2], voffB[2];
#pragma unroll
    for (int i = 0; i < 2; ++i) { int R, C; stage_rc(tid * 16 + i * 8192, R, C); const int Rb = (MODE == 0) ? (64 * (R >> 5) + perm32(R & 31)) : R;
        voffA[i] = (unsigned)(R * K + C) * 2u; voffB[i] = (unsigned)(Rb * K + C) * 2u; }
    constexpr size_t kstep = (size_t)(BK * 2);
    constexpr size_t hstepA = (size_t)HALF * K * 2;
    constexpr size_t hstepB = (size_t)(MODE == 0 ? 32 : 128) * K * 2;
    constexpr size_t tstep = (size_t)256 * K * 2;
    const unsigned ldsw = (unsigned)wid * 1024u;
    const int aoff = lds_byte(wr * 64 + fr, fq * 8), boff = lds_byte(wc * 32 + fr, fq * 8);
#define PG8_SA(b, h) (((b) * 2 + (h)) * HTB)
#define PG8_SB(b, h) ((4 + (b) * 2 + (h)) * HTB)
#define PG8_STAGE(bufoff, gbase, voff) do { _Pragma("unroll") for (int _i = 0; _i < 2; ++_i) \
        __builtin_amdgcn_global_load_lds((const unsigned*)((const char*)(gbase) + (voff)[_i]), (LAS unsigned*)(lds + (bufoff) + ldsw + _i * 8192), 16, 0, 0); } while (0)
#define PG8_LDA(dst, b, h) do { _Pragma("unroll") for (int m = 0; m < 4; ++m) _Pragma("unroll") for (int k = 0; k < 2; ++k) dst[m][k] = *(const LAS bf16x8*)(lds + PG8_SA(b, h) + aoff + m * 2048 + k * 1024); } while (0)
#define PG8_LDB(dst, b, h) do { _Pragma("unroll") for (int n = 0; n < 2; ++n) _Pragma("unroll") for (int k = 0; k < 2; ++k) dst[n][k] = *(const LAS bf16x8*)(lds + PG8_SB(b, h) + boff + n * 2048 + k * 1024); } while (0)
#define PG8_MMA(ai, bj, At, Bt) do { __builtin_amdgcn_s_setprio(1); _Pragma("unroll") for (int m = 0; m < 4; ++m) _Pragma("unroll") for (int n = 0; n < 2; ++n) _Pragma("unroll") for (int k = 0; k < 2; ++k) \
        acc[ai][bj][m][n] = __builtin_amdgcn_mfma_f32_16x16x32_bf16(Bt[n][k], At[m][k], acc[ai][bj][m][n], 0, 0, 0); __builtin_amdgcn_s_setprio(0); } while (0)
#define PG8_WAIT_V(n) asm volatile("s_waitcnt vmcnt(" #n ")" ::: "memory")
#define PG8_WAIT_L(n) asm volatile("s_waitcnt lgkmcnt(" #n ")" ::: "memory")
#define PG8_BAR __builtin_amdgcn_s_barrier()
#define PG8_SCHED __builtin_amdgcn_sched_barrier(0)
#define UNIT_PTRS(u, pa, pb) do { if (MODE == 0 && ((u).pn == 8 || (u).pn == 9)) { pa = Bop + (size_t)(u).pn * tstep; pb = Aop + (size_t)(u).pm * tstep; } \
        else { pa = Aop + (size_t)(u).pm * tstep; pb = Bop + (size_t)(u).pn * tstep; } } while (0)
    Unit cur, nxt; int ui = 0;
    if (!unit_next<nM, nN>(0, G, c, cur)) return;
    f32x4 acc[2][2][4][2];
    acc_init<MODE>(acc, cur, wr, wc, fr, fq, p);
    bf16x8 At[4][2], B0[2][2], B1[2][2];
    const char* cA; const char* cB; UNIT_PTRS(cur, cA, cB);
#define UNIT_X(u) ((const char*)(p.ws + WS_XB) + (size_t)(u).pm * tstep + (size_t)(u).pn * 512 - 16 * kstep)
    const char* cX = UNIT_X(cur);
    PG8_STAGE(PG8_SB(0, 0), cB, voffB); PG8_STAGE(PG8_SA(0, 0), cA, voffA); PG8_STAGE(PG8_SB(0, 1), cB + hstepB, voffB); PG8_STAGE(PG8_SA(0, 1), cA + hstepA, voffA);
    if (wr == 1) PG8_BAR;
    PG8_WAIT_V(4); PG8_BAR;
    PG8_STAGE(PG8_SB(1, 0), cB + kstep, voffB); PG8_STAGE(PG8_SA(1, 0), cA + kstep, voffA); PG8_STAGE(PG8_SB(1, 1), cB + hstepB + kstep, voffB);
    PG8_WAIT_V(6); PG8_BAR;
    for (;;) {
        const bool has_next = unit_next<nM, nN>(ui + 1, G, c, nxt);
        const char* nA = cA; const char* nB = cB; if (has_next) UNIT_PTRS(nxt, nA, nB);
        const char* nX = has_next ? UNIT_X(nxt) : cX;
        for (int t = 0; t < nt; t += 2) {
            const bool last = (t == nt - 2);
            const bool xs1 = (MODE == 1) && (t >= 16), xs2 = (MODE == 1) && (t + 2 >= 16);
            const char* a1 = (xs1 ? cX : cA) + (size_t)(t + 1) * kstep;
            const char* a2 = last ? nA : (xs2 ? cX : cA) + (size_t)(t + 2) * kstep; const char* b2 = last ? nB : (xs2 ? idm : cB) + (size_t)(t + 2) * kstep;
            const char* a3 = a2 + kstep; const char* b3 = b2 + kstep;
            PG8_LDB(B0, 0, 0); PG8_SCHED; PG8_LDA(At, 0, 0); PG8_STAGE(PG8_SA(1, 1), a1 + hstepA, voffA);
            PG8_WAIT_L(8); PG8_BAR; PG8_WAIT_L(0); PG8_MMA(0, 0, At, B0); PG8_BAR; PG8_SCHED;
            PG8_LDB(B1, 0, 1); PG8_STAGE(PG8_SB(0, 0), b2, voffB);
            PG8_BAR; PG8_WAIT_L(0); PG8_MMA(0, 1, At, B1); PG8_BAR;
            PG8_LDA(At, 0, 1); PG8_STAGE(PG8_SA(0, 0), a2, voffA);
            PG8_BAR; PG8_WAIT_L(0); PG8_MMA(1, 0, At, B0); PG8_BAR; PG8_SCHED;
            PG8_STAGE(PG8_SB(0, 1), b2 + hstepB, voffB);
            PG8_WAIT_V(6); PG8_BAR; PG8_MMA(1, 1, At, B1); PG8_BAR;
            PG8_LDB(B0, 1, 0); PG8_SCHED; PG8_LDA(At, 1, 0); PG8_STAGE(PG8_SA(0, 1), a2 + hstepA, voffA);
            PG8_WAIT_L(8); PG8_BAR; PG8_WAIT_L(0); PG8_MMA(0, 0, At, B0); PG8_BAR; PG8_SCHED;
            PG8_LDB(B1, 1, 1); PG8_STAGE(PG8_SB(1, 0), b3, voffB);
            PG8_BAR; PG8_WAIT_L(0); PG8_MMA(0, 1, At, B1); PG8_BAR;
            PG8_LDA(At, 1, 1); PG8_STAGE(PG8_SA(1, 0), a3, voffA);
            PG8_BAR; PG8_WAIT_L(0); PG8_MMA(1, 0, At, B0); PG8_BAR; PG8_SCHED;
            PG8_STAGE(PG8_SB(1, 1), b3 + hstepB, voffB);
            PG8_WAIT_V(6); PG8_BAR; PG8_MMA(1, 1, At, B1); PG8_BAR;
        }
        if (MODE == 0) epi_gemm1(acc, cur, wr, wc, fr, fq, p); else epi_gemm2(acc, cur, wr, wc, fr, fq, p);
        if (!has_next) break;
        acc_init<MODE>(acc, nxt, wr, wc, fr, fq, p);
        cur = nxt; cA = nA; cB = nB; cX = nX; ++ui;
    }
    PG8_WAIT_V(0);
    if (wr == 0) PG8_BAR;
    PG8_BAR;
#undef PG8_SA
#undef PG8_SB
#undef PG8_STAGE
#undef PG8_LDA
#undef PG8_LDB
#undef PG8_MMA
#undef UNIT_PTRS
#undef UNIT_X
}

constexpr int PSTR = 1040;
constexpr int RPB_OFF = 147456;
#define SCHED_FENCE __builtin_amdgcn_sched_barrier(0)
__device__ __forceinline__ void acc8(float (&a)[8], const u32x4 w, const float sgn) {
    a[0] += sgn * bf_lo(w.x); a[1] += sgn * bf_hi(w.x); a[2] += sgn * bf_lo(w.y); a[3] += sgn * bf_hi(w.y);
    a[4] += sgn * bf_lo(w.z); a[5] += sgn * bf_hi(w.z); a[6] += sgn * bf_lo(w.w); a[7] += sgn * bf_hi(w.w);
}
template <int A> __device__ __forceinline__ void pool_a(LAS unsigned char* ldsdst, const bf16_t* Ub, const int pos0, const int S) {
    constexpr int NR = 8 + 2 * A - 1;
    u32x4 rows[NR];
#pragma unroll
    for (int j = 0; j < NR; ++j) { const int pos = pos0 - A + j; const int pc = pos < 0 ? 0 : (pos >= S ? S - 1 : pos); rows[j] = *(const u32x4*)(Ub + (size_t)pc * 512); }
    SCHED_FENCE;
#pragma unroll
    for (int j = 0; j < NR; ++j) { const int pos = pos0 - A + j; if (pos < 0 || pos >= S) rows[j] = (u32x4){0u, 0u, 0u, 0u}; }
    float acc[8];
#pragma unroll
    for (int j = 0; j < 8; ++j) acc[j] = 0.f;
#pragma unroll
    for (int j = 0; j < 2 * A; ++j) acc8(acc, rows[j], 1.0f);
#pragma unroll
    for (int t = 0; t < 8; ++t) {
        const int pos = pos0 + t; const int hi = (pos + A < S) ? pos + A : S, lo = (pos - A > 0) ? pos - A : 0;
        const float inv = 1.0f / (float)(hi - lo);
        const u32x4 cw = rows[A + t];
        float o[8];
        o[0] = acc[0] * inv - bf_lo(cw.x); o[1] = acc[1] * inv - bf_hi(cw.x); o[2] = acc[2] * inv - bf_lo(cw.y); o[3] = acc[3] * inv - bf_hi(cw.y);
        o[4] = acc[4] * inv - bf_lo(cw.z); o[5] = acc[5] * inv - bf_hi(cw.z); o[6] = acc[6] * inv - bf_lo(cw.w); o[7] = acc[7] * inv - bf_hi(cw.w);
        u32x4 w; w.x = cvt_pk_bf16(o[0], o[1]); w.y = cvt_pk_bf16(o[2], o[3]); w.z = cvt_pk_bf16(o[4], o[5]); w.w = cvt_pk_bf16(o[6], o[7]);
        *(LAS u32x4*)(ldsdst + t * PSTR) = w;
        if (t < 7) { acc8(acc, rows[2 * A + t], 1.0f); acc8(acc, rows[t], -1.0f); }
    }
}
__device__ __forceinline__ void mixer_phase(LAS unsigned char* lds, const Params& p, const int G, const int c) {
    const int tid = threadIdx.x, lane = tid & 63, wid = __builtin_amdgcn_readfirstlane(tid >> 6), fr = lane & 15, fq = lane >> 4;
    const bf16_t* aU = (const bf16_t*)(p.ws + WS_ACT); const bf16_t* aGP = aU + ACT_STRIDE; const bf16_t* aQ = aU + 2 * ACT_STRIDE; const bf16_t* aK = aU + 3 * ACT_STRIDE; const bf16_t* aGA = aU + 4 * ACT_STRIDE;
    const bf16_t* VT = (const bf16_t*)(p.ws + WS_VT); const bf16_t* WpT = (const bf16_t*)(p.ws + WS_WP);
    bf16_t* MIX = (bf16_t*)(p.ws + WS_MIX); const float* rsb = (const float*)(p.ws + WS_RS);
    LAS float* rpbs = (LAS float*)(lds + RPB_OFF);
    for (int i = tid; i < 8 * 465; i += 512) rpbs[i] = p.rpb[i];
    __syncthreads();
    for (int it = 0;; ++it) {
        const int L = it * G + c; if (L >= 1280) break;
        const int gr = (L & 7) * 160 + (L >> 3);
        int R, r; if (gr < 1024) { R = 64; r = gr & 63; } else { R = 128; r = (gr - 1024) & 127; }
        const int gr0 = gr - r; const int S = R * 64;
        {
            const int g = wid >> 1, th = wid & 1;
            const int c0 = 128 * g + 8 * fr, tl0 = 32 * th + 8 * fq, pos0 = r * 64 + tl0;
            const bf16_t* Ub = aU + (size_t)gr0 * 64 * 512 + c0;
            LAS unsigned char* dst = lds + (it & 1) * (64 * PSTR) + tl0 * PSTR + c0 * 2;
            if (g == 0) pool_a<1>(dst, Ub, pos0, S); else if (g == 1) pool_a<2>(dst, Ub, pos0, S); else if (g == 2) pool_a<4>(dst, Ub, pos0, S); else pool_a<8>(dst, Ub, pos0, S);
        }
        {
            const int g = wid >> 1, dh = wid & 1;
            bf16x8 bfr[4][4]; u32x2 gw[4][4]; f32x4 psv[4];
            const bf16_t* wb = WpT + (size_t)(g * 128 + 64 * dh + fr) * 128 + 8 * fq;
#pragma unroll
            for (int nt = 0; nt < 4; ++nt)
#pragma unroll
                for (int ks = 0; ks < 4; ++ks) bfr[nt][ks] = *(const bf16x8*)(wb + nt * 16 * 128 + 32 * ks);
            const bf16_t* gb = aGP + ((size_t)gr * 64 + fr) * 512 + 128 * g + 64 * dh + 4 * fq;
#pragma unroll
            for (int mt = 0; mt < 4; ++mt)
#pragma unroll
                for (int nt = 0; nt < 4; ++nt) gw[mt][nt] = *(const u32x2*)(gb + (size_t)mt * 16 * 512 + 16 * nt);
#pragma unroll
            for (int nt = 0; nt < 4; ++nt) psv[nt] = *(const f32x4*)(p.pool_scale + 128 * g + 64 * dh + 16 * nt + 4 * fq);
            float rsm[4];
#pragma unroll
            for (int mt = 0; mt < 4; ++mt) rsm[mt] = rsb[(size_t)gr * 64 + 16 * mt + fr];
            SCHED_FENCE;
            __syncthreads();
            f32x4 acc[4][4];
#pragma unroll
            for (int mt = 0; mt < 4; ++mt)
#pragma unroll
                for (int nt = 0; nt < 4; ++nt) acc[mt][nt] = (f32x4){0.f, 0.f, 0.f, 0.f};
#pragma unroll
            for (int ks = 0; ks < 4; ++ks) {
                bf16x8 af[4];
#pragma unroll
                for (int mt = 0; mt < 4; ++mt) af[mt] = *(const LAS bf16x8*)(lds + (it & 1) * (64 * PSTR) + (16 * mt + fr) * PSTR + (128 * g + 32 * ks + 8 * fq) * 2);
#pragma unroll
                for (int mt = 0; mt < 4; ++mt)
#pragma unroll
                    for (int nt = 0; nt < 4; ++nt) acc[mt][nt] = __builtin_amdgcn_mfma_f32_16x16x32_bf16(bfr[nt][ks], af[mt], acc[mt][nt], 0, 0, 0);
            }
            bf16_t* mb = MIX + ((size_t)gr * 64 + fr) * 1024 + 128 * g + 64 * dh + 4 * fq;
#pragma unroll
            for (int mt = 0; mt < 4; ++mt)
#pragma unroll
                for (int nt = 0; nt < 4; ++nt) {
                    const f32x4 a4 = acc[mt][nt] * rsm[mt]; const u32x2 gg = gw[mt][nt];
                    u32x2 w; w.x = cvt_pk_bf16(a4[0] * psv[nt][0] * bf_lo(gg.x), a4[1] * psv[nt][1] * bf_hi(gg.x)); w.y = cvt_pk_bf16(a4[2] * psv[nt][2] * bf_lo(gg.y), a4[3] * psv[nt][3] * bf_hi(gg.y));
                    *(u32x2*)(mb + (size_t)mt * 16 * 1024 + 16 * nt) = w;
                }
        }
    }
    __syncthreads();
}
constexpr int VREG = 73728;
#define A_BAR() do { SCHED_FENCE; asm volatile("s_waitcnt lgkmcnt(0)" ::: "memory"); __builtin_amdgcn_s_barrier(); SCHED_FENCE; } while (0)
__device__ __forceinline__ void gload16_asm(bf16x8& v, const void* ptr) { asm volatile("global_load_dwordx4 %0, %1, off" : "=v"(v) : "v"(ptr) : "memory"); }
__device__ __forceinline__ void gload4_asm(float& v, const void* ptr) { asm volatile("global_load_dword %0, %1, off" : "=v"(v) : "v"(ptr) : "memory"); }
__device__ __forceinline__ void gload8_asm(u32x2& v, const void* ptr) { asm volatile("global_load_dwordx2 %0, %1, off" : "=v"(v) : "v"(ptr) : "memory"); }
struct AUnit { int gr0, R, r0, h, gA, win; };
__device__ __forceinline__ int win_start(int r, int R) { int s = r - 4; s = s < 0 ? 0 : s; return s > R - 8 ? R - 8 : s; }
__device__ __forceinline__ void attn_decode(int L, int G, AUnit& u) {
    int pp;
    if (G == 256) { const int it = L >> 8, c = L & 255, xcd = c & 7, j = c >> 3; u.h = j & 7; pp = 80 * xcd + 20 * (j >> 3) + it; }
    else { const int xcd = L & 7, q = L >> 3; pp = 80 * xcd + (q >> 3); u.h = q & 7; }
    u.gA = 2 * pp;
    if (u.gA < 1024) { u.R = 64; u.r0 = u.gA & 63; } else { u.R = 128; u.r0 = (u.gA - 1024) & 127; }
    u.gr0 = u.gA - u.r0; u.win = win_start(u.r0, u.R);
}
__device__ __forceinline__ void stage_K(LAS unsigned char* lds, const bf16_t* aK, const AUnit& u, int wid, int lane, int pa) {
    const int rsU = u.win; const int col = 8 * wid + (lane >> 3); const int ch = (lane & 7) ^ ((col >> 1) & 7);
    const bf16_t* src = aK + (size_t)col * 512 + u.h * 64 + ch * 8;
#pragma unroll
    for (int m = 0; m < 9; ++m) { int rw = rsU + m; rw = rw > u.R - 1 ? u.R - 1 : rw;
        if (rw < pa || rw > pa + 8) __builtin_amdgcn_global_load_lds((const unsigned*)(src + (size_t)(u.gr0 + rw) * 64 * 512), (LAS unsigned*)(lds + (wid + 8 * (rw % 9)) * 1024), 16, 0, 0); }
}
__device__ __forceinline__ void stage_V(LAS unsigned char* lds, const bf16_t* VT, const AUnit& u, int wid, int lane, int pa) {
    const int rsU = u.win; const int d = 8 * wid + (lane >> 3); const int ch = (lane & 7) ^ ((d >> 1) & 7);
    const bf16_t* src = VT + (size_t)u.h * 4096 + d * 64 + ch * 8;
#pragma unroll
    for (int m = 0; m < 9; ++m) { int rw = rsU + m; rw = rw > u.R - 1 ? u.R - 1 : rw;
        if (rw < pa || rw > pa + 8) __builtin_amdgcn_global_load_lds((const unsigned*)(src + (size_t)(u.gr0 + rw) * 8 * 4096), (LAS unsigned*)(lds + VREG + (wid + 8 * (rw % 9)) * 1024), 16, 0, 0); }
}
__device__ __forceinline__ void attn_phase(LAS unsigned char* lds, const Params& p, const int G, const int c) {
    const int tid = threadIdx.x, lane = tid & 63, wid = __builtin_amdgcn_readfirstlane(tid >> 6), fr = lane & 15, fq = lane >> 4;
    const bf16_t* aU = (const bf16_t*)(p.ws + WS_ACT); const bf16_t* aQ = aU + 2 * ACT_STRIDE; const bf16_t* aK = aU + 3 * ACT_STRIDE; const bf16_t* aGA = aU + 4 * ACT_STRIDE;
    const bf16_t* VT = (const bf16_t*)(p.ws + WS_VT);
    bf16_t* MIX = (bf16_t*)(p.ws + WS_MIX); const float* rsb = (const float*)(p.ws + WS_RS);
    const LAS float* rpbs = (const LAS float*)(lds + RPB_OFF);
    const int sel = wid >> 2, qb = wid & 3;
    const int ws_ = (qb == 0) ? 0 : (qb == 1) ? 8 : (qb == 2) ? 24 : 32;
    int kofs[2][2], vofs[4];
#pragma unroll
    for (int t = 0; t < 2; ++t) { const int kc = ws_ + 8 * (fr >> 2) + 4 * t + (fr & 3); const int sw = (kc >> 1) & 7; kofs[t][0] = kc * 128 + ((fq ^ sw) << 4); kofs[t][1] = kc * 128 + (((fq | 4) ^ sw) << 4); }
#pragma unroll
    for (int dt = 0; dt < 4; ++dt) { const int d = 16 * dt + fr; vofs[dt] = VREG + d * 128 + ((((ws_ >> 3) + fq) ^ ((d >> 1) & 7)) << 4); }
    const int cq = 16 * qb + fr; int cs = cq - 8; cs = cs < 0 ? 0 : cs; cs = cs > 48 ? 48 : cs;
    int L = c; if (L >= 5120) return;
    if (wid >= 4) __builtin_amdgcn_s_setprio(1);
    AUnit cur, nxt; attn_decode(L, G, cur);
    stage_K(lds, aK, cur, wid, lane, -100);
    int pgr0 = -1, pwin = 0;
    size_t qtok = (size_t)(cur.gA + sel) * 64 + 16 * qb + fr;
    bf16x8 qf0, qf1; u32x2 gw[4];
    SCHED_FENCE;
    gload16_asm(qf0, aQ + qtok * 512 + cur.h * 64 + 8 * fq); gload16_asm(qf1, aQ + qtok * 512 + cur.h * 64 + 32 + 8 * fq);
#pragma unroll
    for (int dt = 0; dt < 4; ++dt) gload8_asm(gw[dt], aGA + qtok * 512 + cur.h * 64 + 16 * dt + 4 * fq);
    float rsq; gload4_asm(rsq, rsb + qtok);
    SCHED_FENCE;
    SCHED_FENCE; asm volatile("s_waitcnt vmcnt(0)" ::: "memory"); SCHED_FENCE;
    for (;;) {
        const int r = cur.r0 + sel; const int rs0 = win_start(r, cur.R); const int sb = rs0 % 9;
        const LAS float* rb = rpbs + cur.h * 465 + (rs0 - r + 7) * 31;
        const int h = cur.h;
        SCHED_FENCE; asm volatile("s_waitcnt vmcnt(4) lgkmcnt(0)" ::: "memory"); __builtin_amdgcn_s_barrier(); SCHED_FENCE;
        asm volatile("" : "+v"(qf0), "+v"(qf1)); SCHED_FENCE;
        stage_V(lds, VT, cur, wid, lane, (pgr0 == cur.gr0) ? pwin : -100);
        pgr0 = cur.gr0; pwin = cur.win;
        SCHED_FENCE;
        const int Ln = L + G; const bool has_next = Ln < 5120;
        nxt = cur; if (has_next) attn_decode(Ln, G, nxt);
        const size_t qtok_n = (size_t)(nxt.gA + sel) * 64 + 16 * qb + fr;
        bf16x8 qn0, qn1; u32x2 gn[4];
        gload16_asm(qn0, aQ + qtok_n * 512 + nxt.h * 64 + 8 * fq); gload16_asm(qn1, aQ + qtok_n * 512 + nxt.h * 64 + 32 + 8 * fq);
#pragma unroll
        for (int dt = 0; dt < 4; ++dt) gload8_asm(gn[dt], aGA + qtok_n * 512 + nxt.h * 64 + 16 * dt + 4 * fq);
        float rsn; gload4_asm(rsn, rsb + qtok_n);
        SCHED_FENCE;
        f32x4 s[8][2];
        {
            const LAS unsigned char* kb = lds;
#pragma unroll
            for (int i = 0; i < 8; ++i)
#pragma unroll
                for (int t = 0; t < 2; ++t) {
                    const int so = ((sb + i >= 9) ? sb + i - 9 : sb + i) * 8192;
                    const bf16x8 k0 = *(const LAS bf16x8*)(kb + kofs[t][0] + so), k1 = *(const LAS bf16x8*)(kb + kofs[t][1] + so);
                    f32x4 z = (f32x4){0.f, 0.f, 0.f, 0.f};
                    z = __builtin_amdgcn_mfma_f32_16x16x32_bf16(k0, qf0, z, 0, 0, 0);
                    z = __builtin_amdgcn_mfma_f32_16x16x32_bf16(k1, qf1, z, 0, 0, 0);
                    s[i][t] = z;
                }
        }
        typedef float f32x2 __attribute__((ext_vector_type(2)));
        f32x2 sv[8][2][2];
        float mx = -1e30f;
#pragma unroll
        for (int t = 0; t < 2; ++t)
#pragma unroll
            for (int jp = 0; jp < 2; ++jp) {
                f32x2 mk1, mk2; int bi2[2];
#pragma unroll
                for (int e = 0; e < 2; ++e) { const int j = 2 * jp + e; const int kc = ws_ + 8 * fq + 4 * t + j; const bool valid = (kc >= cs) && (kc < cs + 16);
                    int bi = kc - cq + 15; bi = bi < 0 ? 0 : bi; bi = bi > 30 ? 30 : bi; bi2[e] = bi; mk1[e] = valid ? 1.0f : 0.0f; mk2[e] = valid ? 0.0f : -1e30f; }
#pragma unroll
                for (int i = 0; i < 8; ++i) { f32x2 bb; bb.x = rb[i * 31 + bi2[0]]; bb.y = rb[i * 31 + bi2[1]];
                    f32x2 x; x.x = s[i][t][2 * jp]; x.y = s[i][t][2 * jp + 1];
                    const f32x2 v = (x + bb) * mk1 + mk2; sv[i][t][jp] = v; mx = fmaxf(mx, fmaxf(v.x, v.y)); }
            }
        mx = xmax4(mx);
        const float mxl = mx * 1.44269504f;
        const f32x2 c2 = (f32x2){1.44269504f, 1.44269504f}, m2 = (f32x2){-mxl, -mxl};
        f32x2 sum2 = (f32x2){0.f, 0.f};
#pragma unroll
        for (int i = 0; i < 8; ++i)
#pragma unroll
            for (int t = 0; t < 2; ++t)
#pragma unroll
                for (int jp = 0; jp < 2; ++jp) { const f32x2 a2 = sv[i][t][jp] * c2 + m2; f32x2 e; e.x = __builtin_amdgcn_exp2f(a2.x); e.y = __builtin_amdgcn_exp2f(a2.y);
                    s[i][t][2 * jp] = e.x; s[i][t][2 * jp + 1] = e.y; sum2 += e; }
        float sum = sum2.x + sum2.y;
        sum = xsum4(sum);
        const float inv0 = 1.0f / sum;
        bf16x8 pf[8];
#pragma unroll
        for (int i = 0; i < 8; ++i) {
            u32x4 pw; pw.x = cvt_pk_bf16(s[i][0][0], s[i][0][1]); pw.y = cvt_pk_bf16(s[i][0][2], s[i][0][3]);
            pw.z = cvt_pk_bf16(s[i][1][0], s[i][1][1]); pw.w = cvt_pk_bf16(s[i][1][2], s[i][1][3]);
            pf[i] = __builtin_bit_cast(bf16x8, pw);
        }
        SCHED_FENCE; asm volatile("s_waitcnt vmcnt(0) lgkmcnt(0)" ::: "memory"); __builtin_amdgcn_s_barrier(); SCHED_FENCE;
        stage_K(lds, aK, nxt, wid, lane, (nxt.gr0 == cur.gr0) ? cur.win : -100);
        SCHED_FENCE;
        asm volatile("" : "+v"(qn0), "+v"(qn1), "+v"(gn[0]), "+v"(gn[1]), "+v"(gn[2]), "+v"(gn[3]), "+v"(gw[0]), "+v"(gw[1]), "+v"(gw[2]), "+v"(gw[3]), "+v"(rsn), "+v"(rsq)); SCHED_FENCE;
        f32x4 o[4];
#pragma unroll
        for (int dt = 0; dt < 4; ++dt) o[dt] = (f32x4){0.f, 0.f, 0.f, 0.f};
        {
            const LAS unsigned char* vb = lds;
#pragma unroll
            for (int i = 0; i < 8; ++i)
#pragma unroll
                for (int dt = 0; dt < 4; ++dt) { const int so = ((sb + i >= 9) ? sb + i - 9 : sb + i) * 8192;
                    const bf16x8 vf = *(const LAS bf16x8*)(vb + vofs[dt] + so); o[dt] = __builtin_amdgcn_mfma_f32_16x16x32_bf16(vf, pf[i], o[dt], 0, 0, 0); }
        }
#pragma unroll
        for (int dt = 0; dt < 4; ++dt) {
            const int chn = h * 64 + 16 * dt + 4 * fq;
            const float inv = inv0 * rsq;
            u32x2 w; w.x = cvt_pk_bf16(o[dt][0] * inv * bf_lo(gw[dt].x), o[dt][1] * inv * bf_hi(gw[dt].x)); w.y = cvt_pk_bf16(o[dt][2] * inv * bf_lo(gw[dt].y), o[dt][3] * inv * bf_hi(gw[dt].y));
            *(u32x2*)(MIX + qtok * 1024 + 512 + chn) = w;
        }
        if (!has_next) break;
        cur = nxt; L = Ln; qtok = qtok_n; qf0 = qn0; qf1 = qn1; rsq = rsn;
#pragma unroll
        for (int dt = 0; dt < 4; ++dt) gw[dt] = gn[dt];
    }
    asm volatile("s_waitcnt vmcnt(0)" ::: "memory"); __builtin_amdgcn_s_barrier();
    __builtin_amdgcn_s_setprio(0);
}


}
__global__ void __launch_bounds__(512, 2) fwd_kernel(Params p) {
    extern __shared__ __attribute__((aligned(16))) unsigned char shm[];
    LAS unsigned char* lds = (LAS unsigned char*)shm;
    const int G = gridDim.x, c = blockIdx.x;
    cg::grid_group grid = cg::this_grid();
#ifndef REP0
#define REP0 1
#endif
#ifndef REP1
#define REP1 1
#endif
#ifndef REP2
#define REP2 1
#endif
#ifndef REP3
#define REP3 1
#endif
    volatile LAS unsigned* bst = (volatile LAS unsigned*)(lds + 147456 + 8 * 465 * 4);
    if (threadIdx.x < 2) bst[threadIdx.x] = 0u;
    __syncthreads();
    XcdBarrier xbar = xcd_barrier_post((unsigned*)(p.ws + WS_BAR), bst);
#define GRID_SYNC() do { if (p.coop) { if (p.use_cg) grid.sync(); else xcd_barrier(xbar); } } while (0)
    if (p.ph_lo <= 0 && 0 < p.ph_hi) { for (int rep = 0; rep < REP0; ++rep) { prep_phase(p, G); GRID_SYNC(); } }
    if (p.ph_lo <= 1 && 1 < p.ph_hi) { for (int rep = 0; rep < REP1; ++rep) { gemm_phase<0>(lds, p, G, c); GRID_SYNC(); } }
    if (p.ph_lo <= 2 && 2 < p.ph_hi) { for (int rep = 0; rep < REP2; ++rep) { mixer_phase(lds, p, G, c); attn_phase(lds, p, G, c); GRID_SYNC(); } }
    if (p.ph_lo <= 3 && 3 < p.ph_hi) { for (int rep = 0; rep < REP3; ++rep) { gemm_phase<1>(lds, p, G, c); if (REP3 > 1 && p.coop) grid.sync(); } }
}

#ifndef N_LAUNCHES
#define N_LAUNCHES 1
#endif

extern "C" void kernel_launch(void* const* d_in, const int* in_sizes, int n_in, void* d_out, int out_size, void* d_ws, size_t ws_size, hipStream_t stream) {
    static int grid = 0;
    if (grid == 0) {
        if (n_in != 10 || ws_size < WS_END) { fprintf(stderr, "kernel_launch: unexpected inputs (n_in %d, ws %zu < %zu)\n", n_in, ws_size, (size_t)WS_END); grid = -1; return; }
        int dev = 0, cus = 0, per_cu = 0;
        (void)hipGetDevice(&dev); (void)hipDeviceGetAttribute(&cus, hipDeviceAttributeMultiprocessorCount, dev);
        if (hipFuncSetAttribute((const void*)fwd_kernel, hipFuncAttributeMaxDynamicSharedMemorySize, LDS_BYTES) != hipSuccess) { fprintf(stderr, "kernel_launch: hipFuncSetAttribute failed\n"); grid = -1; return; }
        (void)hipOccupancyMaxActiveBlocksPerMultiprocessor(&per_cu, (const void*)fwd_kernel, 512, LDS_BYTES);
        (void)hipGetLastError();
        if (per_cu < 1) per_cu = 1;
        grid = cus;
    }
    if (grid < 0) return;
    Params p{};
    p.xp = (const float*)d_in[0]; p.xs = (const float*)d_in[1]; p.norm_g = (const float*)d_in[2]; p.w_in = (const float*)d_in[3]; p.w_pool = (const float*)d_in[4];
    p.pool_scale = (const float*)d_in[5]; p.qg = (const float*)d_in[6]; p.kg = (const float*)d_in[7]; p.rpb = (const float*)d_in[8]; p.w_out = (const float*)d_in[9];
    p.out = (float*)d_out; p.ws = (unsigned char*)d_ws; p.use_cg = 0;
    (void)hipMemsetAsync((char*)d_ws + WS_BAR, 0, XCD_BAR_WORDS * 4, stream);
#if N_LAUNCHES == 1
    p.ph_lo = 0; p.ph_hi = 4; p.coop = 1;
    void* args[] = {&p};
    hipError_t e = hipLaunchCooperativeKernel((const void*)fwd_kernel, dim3(grid), dim3(512), args, LDS_BYTES, stream);
    if (e != hipSuccess) fprintf(stderr, "cooperative launch failed: %s (grid %d)\n", hipGetErrorString(e), grid);
#else
    for (int ph = 0; ph < 4; ++ph) { p.ph_lo = ph; p.ph_hi = ph + 1; p.coop = 0; hipLaunchKernelGGL(fwd_kernel, dim3(grid), dim3(512), LDS_BYTES, stream, p); }
#endif
}
```

```cpp
#include <hip/hip_runtime.h>
#include <hip/hip_cooperative_groups.h>
#include <cstdio>
namespace cg = cooperative_groups;

#define LAS __attribute__((address_space(3)))
typedef unsigned short bf16_t;
typedef short bf16x8 __attribute__((ext_vector_type(8)));
typedef float f32x4 __attribute__((ext_vector_type(4)));
typedef unsigned u32x4 __attribute__((ext_vector_type(4)));
typedef unsigned u32x2 __attribute__((ext_vector_type(2)));

namespace {
constexpr int NTOK = 81920, NTOK_P = 65536;
constexpr float EPS = 1e-6f;
constexpr int BM = 256, BK = 64, HALF = 128, HTB = HALF * BK * 2, STAGE_BYTES = 8 * HTB;
constexpr int LDS_BYTES = 147456 + 8 * 465 * 4 + 16;
constexpr size_t ACT_STRIDE = (size_t)NTOK * 512;
constexpr size_t WS_XB = 0;
constexpr size_t WS_RS = WS_XB + (size_t)NTOK * 1024 * 2;
constexpr size_t WS_WIN = WS_RS + (size_t)NTOK * 4;
constexpr size_t WS_WOUT = WS_WIN + (size_t)3072 * 1024 * 2;
constexpr size_t WS_WP = WS_WOUT + (size_t)1024 * 1024 * 2;
constexpr size_t WS_ACT = WS_WP + (size_t)4 * 128 * 128 * 2;
constexpr size_t WS_VT = WS_ACT + 5 * ACT_STRIDE * 2;
constexpr size_t WS_MIX = WS_VT + ACT_STRIDE * 2;
constexpr size_t WS_RSI = WS_MIX + (size_t)NTOK * 1024 * 2;
constexpr size_t WS_ID = WS_RSI + (size_t)NTOK * 4;
constexpr size_t WS_BAR = WS_ID + (size_t)256 * 1024 * 2;
constexpr size_t WS_END = WS_BAR + 16384;

struct Params {
    const float* xp; const float* xs; const float* norm_g; const float* w_in; const float* w_pool; const float* pool_scale;
    const float* qg; const float* kg; const float* rpb; const float* w_out; float* out; unsigned char* ws;
    int ph_lo, ph_hi, coop, use_cg;
};
#define XB_TMO      128
#define XB_XCNT(j)  (256  + 64 * (j))
#define XB_XSUB(j)  (1280 + 64 * (j))
#define XB_XGEN(j)  (2304 + 64 * (j))
#define XB_TOP      3328
#define XB_TOPGEN   3392
#define XCD_BAR_WORDS 3456
#define XB_SPIN_CAP (1u << 22)
__device__ __forceinline__ unsigned xb_ld(unsigned* p)              { return __hip_atomic_load(p, __ATOMIC_RELAXED, __HIP_MEMORY_SCOPE_AGENT); }
__device__ __forceinline__ unsigned xb_add(unsigned* p, unsigned v) { return __hip_atomic_fetch_add(p, v, __ATOMIC_RELAXED, __HIP_MEMORY_SCOPE_AGENT); }
__device__ __forceinline__ unsigned xb_xcc_id() { return (unsigned)__builtin_amdgcn_s_getreg((3 << 11) | 20) & 0xFu; }
#define XB_SPIN(cond, bar) do { unsigned _sp = 0; while (cond) { __builtin_amdgcn_s_sleep(1); \
    if ((++_sp & 255u) == 0u) { if (xb_ld(&(bar)[XB_TMO])) break; if (_sp > XB_SPIN_CAP) { atomicAdd(&(bar)[XB_TMO], 1u); break; } } } } while (0)
struct XcdBarrier { unsigned* bar; unsigned x; volatile LAS unsigned* st; };
__device__ __forceinline__ XcdBarrier xcd_barrier_post(unsigned* bar, volatile LAS unsigned* st) {
    XcdBarrier b; b.bar = bar; b.x = xb_xcc_id(); b.st = st;
    if (threadIdx.x == 0) (void)xb_add(&bar[XB_XCNT(b.x)], 1u);
    return b;
}
__device__ __forceinline__ void xcd_barrier_complete(unsigned* bar, unsigned x, unsigned& nloc, unsigned& nx) {
    const unsigned G = gridDim.x * gridDim.y * gridDim.z;
    unsigned sum, cnt, mine, sp = 0u;
    for (;;) {
        sum = 0u; cnt = 0u; mine = 0u;
#pragma unroll
        for (unsigned j = 0; j < 16; ++j) { const unsigned c = xb_ld(&bar[XB_XCNT(j)]); sum += c; cnt += (c > 0u) ? 1u : 0u; mine = (j == x) ? c : mine; }
        if (sum == G) break;
        __builtin_amdgcn_s_sleep(1);
        if ((++sp & 255u) == 0u) { if (xb_ld(&bar[XB_TMO])) break; if (sp > XB_SPIN_CAP) { atomicAdd(&bar[XB_TMO], 1u); break; } }
    }
    nloc = mine > 0u ? mine : 1u; nx = cnt > 0u ? cnt : 1u;
}
__device__ __forceinline__ void xcd_barrier(const XcdBarrier& b) {
    asm volatile("s_waitcnt vmcnt(0) lgkmcnt(0)" ::: "memory");
    __syncthreads();
    if (threadIdx.x == 0) {
        unsigned* bar = b.bar;
        __builtin_amdgcn_s_waitcnt(0);
        unsigned nloc = b.st[0], nx = b.st[1];
        if (nloc == 0u) { xcd_barrier_complete(bar, b.x, nloc, nx); b.st[0] = nloc; b.st[1] = nx; }
        const unsigned old = xb_add(&bar[XB_XSUB(b.x)], 1u);
        const unsigned gen = old / nloc;
        if (old + 1u == (gen + 1u) * nloc) {
            __builtin_amdgcn_fence(__ATOMIC_RELEASE, "agent");
            asm volatile("s_waitcnt vmcnt(0)" ::: "memory");
            const unsigned og = xb_add(&bar[XB_TOP], 1u);
            const unsigned tg = og / nx;
            if (og + 1u == (tg + 1u) * nx) xb_add(&bar[XB_TOPGEN], 1u);
            else XB_SPIN(xb_ld(&bar[XB_TOPGEN]) == tg, bar);
            __builtin_amdgcn_fence(__ATOMIC_ACQUIRE, "agent");
            xb_add(&bar[XB_XGEN(b.x)], 1u);
            asm volatile("s_waitcnt vmcnt(0)" ::: "memory");
        } else {
            XB_SPIN(xb_ld(&bar[XB_XGEN(b.x)]) == gen, bar);
            __builtin_amdgcn_fence(__ATOMIC_ACQUIRE, "agent");
            asm volatile("s_waitcnt vmcnt(0)" ::: "memory");
        }
    }
    __syncthreads();
}

__device__ __forceinline__ unsigned cvt_pk_bf16(float lo, float hi) { unsigned r; asm("v_cvt_pk_bf16_f32 %0, %1, %2" : "=v"(r) : "v"(lo), "v"(hi)); return r; }
__device__ __forceinline__ float bf_lo(unsigned w) { return __uint_as_float(w << 16); }
__device__ __forceinline__ float bf_hi(unsigned w) { return __uint_as_float(w & 0xffff0000u); }
typedef unsigned xr_u2 __attribute__((ext_vector_type(2)));
__device__ __forceinline__ float xsum4(float x) {
    xr_u2 r = __builtin_amdgcn_permlane32_swap(__float_as_uint(x), __float_as_uint(x), false, false); const float s = __uint_as_float(r.x) + __uint_as_float(r.y);
    xr_u2 q = __builtin_amdgcn_permlane16_swap(__float_as_uint(s), __float_as_uint(s), false, false); return __uint_as_float(q.x) + __uint_as_float(q.y);
}
__device__ __forceinline__ float xmax4(float x) {
    xr_u2 r = __builtin_amdgcn_permlane32_swap(__float_as_uint(x), __float_as_uint(x), false, false); const float s = fmaxf(__uint_as_float(r.x), __uint_as_float(r.y));
    xr_u2 q = __builtin_amdgcn_permlane16_swap(__float_as_uint(s), __float_as_uint(s), false, false); return fmaxf(__uint_as_float(q.x), __uint_as_float(q.y));
}
__device__ __forceinline__ float silu_f(float v) { return v * __builtin_amdgcn_rcpf(1.0f + __expf(-v)); }

__device__ __forceinline__ int lds_byte(int r, int c) { const int st = (r >> 4) * 2 + (c >> 5), rr = r & 15, cc = c & 31, ob = rr * 64 + cc * 2; return st * 1024 + (ob ^ (((ob >> 9) & 1) << 5)); }
__device__ __forceinline__ void stage_rc(int b, int& R, int& C) { const int st = b / 1024, sb = b % 1024, swz = sb ^ (((sb >> 9) & 1) << 5); R = (st >> 1) * 16 + swz / 64; C = (st & 1) * 32 + (swz % 64) / 2; }
__device__ __forceinline__ int perm32(int rho) { const int n = rho >> 4, i = rho & 15; return 8 * (i >> 2) + 4 * n + (i & 3); }

struct Unit { int pm, pn; };
template <int nM, int nN> __device__ __forceinline__ bool unit_next(int i, int G, int c, Unit& u) {
    constexpr int nwg = nM * nN; const long L = (long)i * G + c; if (L >= nwg) return false;
    int wgid = (int)L; { constexpr int q = nwg / 8, r = nwg % 8; const int xcd = wgid % 8, off = wgid / 8; wgid = (xcd < r ? xcd * (q + 1) : r * (q + 1) + (xcd - r) * q) + off; }
    constexpr int nig = 8 * nN; const int gid = wgid / nig, fm = gid * 8, gsz = (nM - fm) < 8 ? (nM - fm) : 8;
    u.pm = fm + ((wgid % nig) % gsz); u.pn = (wgid % nig) / gsz; return true;
}

__device__ __forceinline__ void prep_phase(const Params& p, int G) {
    const int tid = threadIdx.x, lane = tid & 63, wid = tid >> 6;
    bf16_t* xb = (bf16_t*)(p.ws + WS_XB); float* rsb = (float*)(p.ws + WS_RS); float* rsib = (float*)(p.ws + WS_RSI);
    const int nw = G * 8;
    const int gt = blockIdx.x * 512 + tid, T = G * 512; const bool fastw = (T == 131072);
    bf16_t* WinT = (bf16_t*)(p.ws + WS_WIN); bf16_t* WoutT = (bf16_t*)(p.ws + WS_WOUT);
#define PREP_LOAD(dst, row) do { const float* _xr = ((row) < NTOK_P) ? p.xp + (size_t)(row) * 1024 : p.xs + (size_t)((row) - NTOK_P) * 1024; \
        dst[0] = __builtin_nontemporal_load((const f32x4*)(_xr + lane * 8)); dst[1] = __builtin_nontemporal_load((const f32x4*)(_xr + lane * 8 + 4)); \
        dst[2] = __builtin_nontemporal_load((const f32x4*)(_xr + 512 + lane * 8)); dst[3] = __builtin_nontemporal_load((const f32x4*)(_xr + 512 + lane * 8 + 4)); } while (0)
#define PREP_DO(v, row) do { float ss = 0.f; \
        _Pragma("unroll") for (int k = 0; k < 4; ++k) _Pragma("unroll") for (int j = 0; j < 4; ++j) ss += v[k][j] * v[k][j]; \
        _Pragma("unroll") for (int o = 32; o >= 1; o >>= 1) ss += __shfl_xor(ss, o); \
        const float rsc = rsqrtf(ss * (1.0f / 1024.0f) + EPS); u32x4 w0, w1; if (lane == 0) { rsb[row] = rsc; rsib[row] = sqrtf(ss * (1.0f / 1024.0f) + EPS); } \
        w0.x = cvt_pk_bf16(v[0][0] * rsc, v[0][1] * rsc); w0.y = cvt_pk_bf16(v[0][2] * rsc, v[0][3] * rsc); w0.z = cvt_pk_bf16(v[1][0] * rsc, v[1][1] * rsc); w0.w = cvt_pk_bf16(v[1][2] * rsc, v[1][3] * rsc); \
        w1.x = cvt_pk_bf16(v[2][0] * rsc, v[2][1] * rsc); w1.y = cvt_pk_bf16(v[2][2] * rsc, v[2][3] * rsc); w1.z = cvt_pk_bf16(v[3][0] * rsc, v[3][1] * rsc); w1.w = cvt_pk_bf16(v[3][2] * rsc, v[3][3] * rsc); \
        *(u32x4*)(xb + (size_t)(row) * 1024 + lane * 8) = w0; *(u32x4*)(xb + (size_t)(row) * 1024 + 512 + lane * 8) = w1; } while (0)
    {
        int row = blockIdx.x * 8 + wid;
        f32x4 va[4], vb[4], vc[4];
        if (row < NTOK) PREP_LOAD(va, row);
        if (row + nw < NTOK) PREP_LOAD(vb, row + nw);
        int itx = 0;
        for (; row < NTOK; row += 3 * nw, ++itx) {
            if (row + 2 * nw < NTOK) PREP_LOAD(vc, row + 2 * nw);
            float wv[8]; const bool wdo = fastw && itx < 4; int wn = 0, wk8 = 0;
            if (wdo) {
                if (itx < 3) { const int idx = gt + itx * T; wn = idx % 3072; wk8 = idx / 3072;
#pragma unroll
                    for (int j = 0; j < 8; ++j) wv[j] = p.w_in[(size_t)(wk8 * 8 + j) * 3072 + wn] * p.norm_g[wk8 * 8 + j]; }
                else { wn = gt % 1024; wk8 = gt / 1024;
#pragma unroll
                    for (int j = 0; j < 8; ++j) wv[j] = p.w_out[(size_t)(wk8 * 8 + j) * 1024 + wn]; }
            }
            PREP_DO(va, row);
            if (row + nw < NTOK) { if (row + 3 * nw < NTOK) PREP_LOAD(va, row + 3 * nw); PREP_DO(vb, row + nw); }
            if (row + 2 * nw < NTOK) { if (row + 4 * nw < NTOK) PREP_LOAD(vb, row + 4 * nw); PREP_DO(vc, row + 2 * nw); }
            if (wdo) { u32x4 w; w.x = cvt_pk_bf16(wv[0], wv[1]); w.y = cvt_pk_bf16(wv[2], wv[3]); w.z = cvt_pk_bf16(wv[4], wv[5]); w.w = cvt_pk_bf16(wv[6], wv[7]);
                *(u32x4*)((itx < 3 ? WinT : WoutT) + (size_t)wn * 1024 + wk8 * 8) = w; }
        }
    }
#undef PREP_LOAD
#undef PREP_DO
    bf16_t* WpT = (bf16_t*)(p.ws + WS_WP);
    if (!fastw)
    for (int idx = gt; idx < 3072 * 128; idx += T) {
        const int n = idx % 3072, k8 = idx / 3072; float v[8];
#pragma unroll
        for (int j = 0; j < 8; ++j) v[j] = p.w_in[(size_t)(k8 * 8 + j) * 3072 + n] * p.norm_g[k8 * 8 + j];
        u32x4 w; w.x = cvt_pk_bf16(v[0], v[1]); w.y = cvt_pk_bf16(v[2], v[3]); w.z = cvt_pk_bf16(v[4], v[5]); w.w = cvt_pk_bf16(v[6], v[7]);
        *(u32x4*)(WinT + (size_t)n * 1024 + k8 * 8) = w;
    }
    if (!fastw)
    for (int idx = gt; idx < 1024 * 128; idx += T) {
        const int n = idx % 1024, k8 = idx / 1024; float v[8];
#pragma unroll
        for (int j = 0; j < 8; ++j) v[j] = p.w_out[(size_t)(k8 * 8 + j) * 1024 + n];
        u32x4 w; w.x = cvt_pk_bf16(v[0], v[1]); w.y = cvt_pk_bf16(v[2], v[3]); w.z = cvt_pk_bf16(v[4], v[5]); w.w = cvt_pk_bf16(v[6], v[7]);
        *(u32x4*)(WoutT + (size_t)n * 1024 + k8 * 8) = w;
    }
    for (int idx = gt; idx < 256 * 128; idx += T) {
        const int n = idx >> 7, k8 = idx & 127; u32x4 w = (u32x4){0u, 0u, 0u, 0u};
        if (k8 == (n >> 3)) { const unsigned one = 0x3F80u << (16 * (n & 1)); const int wd = (n & 7) >> 1; w.x = wd == 0 ? one : 0u; w.y = wd == 1 ? one : 0u; w.z = wd == 2 ? one : 0u; w.w = wd == 3 ? one : 0u; }
        *(u32x4*)((bf16_t*)(p.ws + WS_ID) + (size_t)n * 1024 + k8 * 8) = w;
    }
    for (int idx = gt; idx < 4 * 128 * 16; idx += T) {
        const int d = idx % 128, c8 = (idx / 128) % 16, g = idx / 2048; float v[8];
#pragma unroll
        for (int j = 0; j < 8; ++j) v[j] = p.w_pool[(size_t)(g * 128 + c8 * 8 + j) * 128 + d];
        u32x4 w; w.x = cvt_pk_bf16(v[0], v[1]); w.y = cvt_pk_bf16(v[2], v[3]); w.z = cvt_pk_bf16(v[4], v[5]); w.w = cvt_pk_bf16(v[6], v[7]);
        *(u32x4*)(WpT + (size_t)(g * 128 + d) * 128 + c8 * 8) = w;
    }
}

__device__ __forceinline__ void epi_gemm1(const f32x4 (&acc)[2][2][4][2], const Unit& u, int wr, int wc, int fr, int fq, const Params& p) {
    if (u.pn == 8 || u.pn == 9) {
        bf16_t* VT = (bf16_t*)(p.ws + WS_VT);
        const int gr = u.pm * 4 + wc;
#pragma unroll
        for (int ai = 0; ai < 2; ++ai)
#pragma unroll
            for (int m = 0; m < 4; ++m) {
                const int vc = (u.pn - 8) * 256 + ai * 128 + wr * 64 + m * 16 + fr; const int h = vc >> 6, d = vc & 63;
                bf16_t* dst = VT + ((size_t)(gr * 8 + h) * 64 + d) * 64 + fq * 8;
#pragma unroll
                for (int bj = 0; bj < 2; ++bj) { const f32x4 v0 = acc[ai][bj][m][0], v1 = acc[ai][bj][m][1];
                    u32x4 w; w.x = cvt_pk_bf16(v0[0], v0[1]); w.y = cvt_pk_bf16(v0[2], v0[3]); w.z = cvt_pk_bf16(v1[0], v1[1]); w.w = cvt_pk_bf16(v1[2], v1[3]);
                    __builtin_nontemporal_store(w, (u32x4*)(dst + 32 * bj)); }
            }
    } else {
        const int kind = u.pn < 8 ? (u.pn >> 1) : 4;
        bf16_t* base = (bf16_t*)(p.ws + WS_ACT) + (size_t)kind * ACT_STRIDE;
        const int row0 = u.pm * 256 + wr * 64 + fr, col0 = (u.pn & 1) * 256 + wc * 64 + fq * 8;
        f32x4 gv[2][2];
        if (kind == 2 || kind == 3) { const float* g = kind == 2 ? p.qg : p.kg; const float sc = kind == 2 ? 0.125f : 1.0f;
#pragma unroll
            for (int bj = 0; bj < 2; ++bj)
#pragma unroll
                for (int n = 0; n < 2; ++n) gv[bj][n] = *(const f32x4*)(g + 32 * bj + 8 * fq + 4 * n) * sc; }
#pragma unroll
        for (int ai = 0; ai < 2; ++ai)
#pragma unroll
            for (int m = 0; m < 4; ++m) {
                const int row = row0 + ai * 128 + m * 16;
                f32x4 v[2][2];
#pragma unroll
                for (int bj = 0; bj < 2; ++bj)
#pragma unroll
                    for (int n = 0; n < 2; ++n) v[bj][n] = acc[ai][bj][m][n];
                if (kind == 2 || kind == 3) {
                    float ss = 0.f;
#pragma unroll
                    for (int bj = 0; bj < 2; ++bj)
#pragma unroll
                        for (int n = 0; n < 2; ++n) { const f32x4 x = v[bj][n]; ss += (x[0] * x[0] + x[1] * x[1]) + (x[2] * x[2] + x[3] * x[3]); }
                    ss = xsum4(ss);
                    const float sc = rsqrtf(ss * (1.0f / 64.0f) + EPS);
#pragma unroll
                    for (int bj = 0; bj < 2; ++bj)
#pragma unroll
                        for (int n = 0; n < 2; ++n) v[bj][n] = v[bj][n] * gv[bj][n] * sc;
                } else if (kind == 1 || kind == 4) {
#pragma unroll
                    for (int bj = 0; bj < 2; ++bj)
#pragma unroll
                        for (int n = 0; n < 2; ++n)
#pragma unroll
                            for (int j = 0; j < 4; ++j) v[bj][n][j] = silu_f(v[bj][n][j]);
                }
                bf16_t* dst = base + (size_t)row * 512 + col0;
#pragma unroll
                for (int bj = 0; bj < 2; ++bj) { u32x4 w; w.x = cvt_pk_bf16(v[bj][0][0], v[bj][0][1]); w.y = cvt_pk_bf16(v[bj][0][2], v[bj][0][3]); w.z = cvt_pk_bf16(v[bj][1][0], v[bj][1][1]); w.w = cvt_pk_bf16(v[bj][1][2], v[bj][1][3]);
                    __builtin_nontemporal_store(w, (u32x4*)(dst + 32 * bj)); }
            }
    }
}
__device__ __forceinline__ void epi_gemm2(const f32x4 (&acc)[2][2][4][2], const Unit& u, int wr, int wc, int fr, int fq, const Params& p) {
    const int row0 = u.pm * 256 + wr * 64 + fr, col0 = u.pn * 256 + wc * 32 + 4 * fq;
    const float* rsi = (const float*)(p.ws + WS_RSI) + row0; float ri[2][4];
#pragma unroll
    for (int ai = 0; ai < 2; ++ai)
#pragma unroll
        for (int m = 0; m < 4; ++m) ri[ai][m] = rsi[ai * 128 + m * 16];
#pragma unroll
    for (int ai = 0; ai < 2; ++ai)
#pragma unroll
        for (int m = 0; m < 4; ++m) {
            const int row = row0 + ai * 128 + m * 16;
            float* orow = p.out + (size_t)row * 1024 + col0;
#pragma unroll
            for (int bj = 0; bj < 2; ++bj)
#pragma unroll
                for (int n = 0; n < 2; ++n) *(f32x4*)(orow + bj * 128 + n * 16) = acc[ai][bj][m][n] * ri[ai][m];
        }
}

template <int MODE> __device__ __forceinline__ void acc_init(f32x4 (&acc)[2][2][4][2], const Unit& u, int wr, int wc, int fr, int fq, const Params& p) {
    if (MODE == 0) {
#pragma unroll
        for (int a = 0; a < 2; ++a)
#pragma unroll
            for (int b = 0; b < 2; ++b)
#pragma unroll
                for (int m = 0; m < 4; ++m)
#pragma unroll
                    for (int n = 0; n < 2; ++n) acc[a][b][m][n] = (f32x4){0.f, 0.f, 0.f, 0.f};
    } else {
#pragma unroll
        for (int a = 0; a < 2; ++a)
#pragma unroll
            for (int b = 0; b < 2; ++b)
#pragma unroll
                for (int m = 0; m < 4; ++m)
#pragma unroll
                    for (int n = 0; n < 2; ++n) acc[a][b][m][n] = (f32x4){0.f, 0.f, 0.f, 0.f};
    }
}
template <int MODE>
__device__ __forceinline__ void gemm_phase(LAS unsigned char* lds, const Params& p, const int G, const int c) {
    constexpr int K = 1024, nt = (MODE == 0 ? 16 : 20);
    constexpr int nM = NTOK / 256, nN = (MODE == 0 ? 12 : 4);
    const char* Aop = (const char*)(p.ws + (MODE == 0 ? WS_XB : WS_MIX));
    const char* idm = (const char*)(p.ws + WS_ID) - 16 * (size_t)(BK * 2);
    const char* Bop = (const char*)(p.ws + (MODE == 0 ? WS_WIN : WS_WOUT));
    const int tid = threadIdx.x, wid = __builtin_amdgcn_readfirstlane(tid >> 6), lane = tid & 63, wr = wid >> 2, wc = wid & 3, fr = lane & 15, fq = lane >> 4;
    unsigned voffA[2], voffB[2];
#pragma unroll
    for (int i = 0; i < 2; ++i) { int R, C; stage_rc(tid * 16 + i * 8192, R, C); const int Rb = (MODE == 0) ? (64 * (R >> 5) + perm32(R & 31)) : R;
        voffA[i] = (unsigned)(R * K + C) * 2u; voffB[i] = (unsigned)(Rb * K + C) * 2u; }
    constexpr size_t kstep = (size_t)(BK * 2);
    constexpr size_t hstepA = (size_t)HALF * K * 2;
    constexpr size_t hstepB = (size_t)(MODE == 0 ? 32 : 128) * K * 2;
    constexpr size_t tstep = (size_t)256 * K * 2;
    const unsigned ldsw = (unsigned)wid * 1024u;
    const int aoff = lds_byte(wr * 64 + fr, fq * 8), boff = lds_byte(wc * 32 + fr, fq * 8);
#define PG8_SA(b, h) (((b) * 2 + (h)) * HTB)
#define PG8_SB(b, h) ((4 + (b) * 2 + (h)) * HTB)
#define PG8_STAGE(bufoff, gbase, voff) do { _Pragma("unroll") for (int _i = 0; _i < 2; ++_i) \
        __builtin_amdgcn_global_load_lds((const unsigned*)((const char*)(gbase) + (voff)[_i]), (LAS unsigned*)(lds + (bufoff) + ldsw + _i * 8192), 16, 0, 0); } while (0)
#define PG8_LDA(dst, b, h) do { _Pragma("unroll") for (int m = 0; m < 4; ++m) _Pragma("unroll") for (int k = 0; k < 2; ++k) dst[m][k] = *(const LAS bf16x8*)(lds + PG8_SA(b, h) + aoff + m * 2048 + k * 1024); } while (0)
#define PG8_LDB(dst, b, h) do { _Pragma("unroll") for (int n = 0; n < 2; ++n) _Pragma("unroll") for (int k = 0; k < 2; ++k) dst[n][k] = *(const LAS bf16x8*)(lds + PG8_SB(b, h) + boff + n * 2048 + k * 1024); } while (0)
#define PG8_MMA(ai, bj, At, Bt) do { __builtin_amdgcn_s_setprio(1); _Pragma("unroll") for (int m = 0; m < 4; ++m) _Pragma("unroll") for (int n = 0; n < 2; ++n) _Pragma("unroll") for (int k = 0; k < 2; ++k) \
        acc[ai][bj][m][n] = __builtin_amdgcn_mfma_f32_16x16x32_bf16(Bt[n][k], At[m][k], acc[ai][bj][m][n], 0, 0, 0); __builtin_amdgcn_s_setprio(0); } while (0)
#define PG8_WAIT_V(n) asm volatile("s_waitcnt vmcnt(" #n ")" ::: "memory")
#define PG8_WAIT_L(n) asm volatile("s_waitcnt lgkmcnt(" #n ")" ::: "memory")
#define PG8_BAR __builtin_amdgcn_s_barrier()
#define PG8_SCHED __builtin_amdgcn_sched_barrier(0)
#define UNIT_PTRS(u, pa, pb) do { if (MODE == 0 && ((u).pn == 8 || (u).pn == 9)) { pa = Bop + (size_t)(u).pn * tstep; pb = Aop + (size_t)(u).pm * tstep; } \
        else { pa = Aop + (size_t)(u).pm * tstep; pb = Bop + (size_t)(u).pn * tstep; } } while (0)
    Unit cur, nxt; int ui = 0;
    if (!unit_next<nM, nN>(0, G, c, cur)) return;
    f32x4 acc[2][2][4][2];
    acc_init<MODE>(acc, cur, wr, wc, fr, fq, p);
    bf16x8 At[4][2], B0[2][2], B1[2][2];
    const char* cA; const char* cB; UNIT_PTRS(cur, cA, cB);
#define UNIT_X(u) ((const char*)(p.ws + WS_XB) + (size_t)(u).pm * tstep + (size_t)(u).pn * 512 - 16 * kstep)
    const char* cX = UNIT_X(cur);
    PG8_STAGE(PG8_SB(0, 0), cB, voffB); PG8_STAGE(PG8_SA(0, 0), cA, voffA); PG8_STAGE(PG8_SB(0, 1), cB + hstepB, voffB); PG8_STAGE(PG8_SA(0, 1), cA + hstepA, voffA);
    if (wr == 1) PG8_BAR;
    PG8_WAIT_V(4); PG8_BAR;
    PG8_STAGE(PG8_SB(1, 0), cB + kstep, voffB); PG8_STAGE(PG8_SA(1, 0), cA + kstep, voffA); PG8_STAGE(PG8_SB(1, 1), cB + hstepB + kstep, voffB);
    PG8_WAIT_V(6); PG8_BAR;
    for (;;) {
        const bool has_next = unit_next<nM, nN>(ui + 1, G, c, nxt);
        const char* nA = cA; const char* nB = cB; if (has_next) UNIT_PTRS(nxt, nA, nB);
        const char* nX = has_next ? UNIT_X(nxt) : cX;
        for (int t = 0; t < nt; t += 2) {
            const bool last = (t == nt - 2);
            const bool xs1 = (MODE == 1) && (t >= 16), xs2 = (MODE == 1) && (t + 2 >= 16);
            const char* a1 = (xs1 ? cX : cA) + (size_t)(t + 1) * kstep;
            const char* a2 = last ? nA : (xs2 ? cX : cA) + (size_t)(t + 2) * kstep; const char* b2 = last ? nB : (xs2 ? idm : cB) + (size_t)(t + 2) * kstep;
            const char* a3 = a2 + kstep; const char* b3 = b2 + kstep;
            PG8_LDB(B0, 0, 0); PG8_SCHED; PG8_LDA(At, 0, 0); PG8_STAGE(PG8_SA(1, 1), a1 + hstepA, voffA);
            PG8_WAIT_L(8); PG8_BAR; PG8_WAIT_L(0); PG8_MMA(0, 0, At, B0); PG8_BAR; PG8_SCHED;
            PG8_LDB(B1, 0, 1); PG8_STAGE(PG8_SB(0, 0), b2, voffB);
            PG8_BAR; PG8_WAIT_L(0); PG8_MMA(0, 1, At, B1); PG8_BAR;
            PG8_LDA(At, 0, 1); PG8_STAGE(PG8_SA(0, 0), a2, voffA);
            PG8_BAR; PG8_WAIT_L(0); PG8_MMA(1, 0, At, B0); PG8_BAR; PG8_SCHED;
            PG8_STAGE(PG8_SB(0, 1), b2 + hstepB, voffB);
            PG8_WAIT_V(6); PG8_BAR; PG8_MMA(1, 1, At, B1); PG8_BAR;
            PG8_LDB(B0, 1, 0); PG8_SCHED; PG8_LDA(At, 1, 0); PG8_STAGE(PG8_SA(0, 1), a2 + hstepA, voffA);
            PG8_WAIT_L(8); PG8_BAR; PG8_WAIT_L(0); PG8_MMA(0, 0, At, B0); PG8_BAR; PG8_SCHED;
            PG8_LDB(B1, 1, 1); PG8_STAGE(PG8_SB(1, 0), b3, voffB);
            PG8_BAR; PG8_WAIT_L(0); PG8_MMA(0, 1, At, B1); PG8_BAR;
            PG8_LDA(At, 1, 1); PG8_STAGE(PG8_SA(1, 0), a3, voffA);
            PG8_BAR; PG8_WAIT_L(0); PG8_MMA(1, 0, At, B0); PG8_BAR; PG8_SCHED;
            PG8_STAGE(PG8_SB(1, 1), b3 + hstepB, voffB);
            PG8_WAIT_V(6); PG8_BAR; PG8_MMA(1, 1, At, B1); PG8_BAR;
        }
        if (MODE == 0) epi_gemm1(acc, cur, wr, wc, fr, fq, p); else epi_gemm2(acc, cur, wr, wc, fr, fq, p);
        if (!has_next) break;
        acc_init<MODE>(acc, nxt, wr, wc, fr, fq, p);
        cur = nxt; cA = nA; cB = nB; cX = nX; ++ui;
    }
    PG8_WAIT_V(0);
    if (wr == 0) PG8_BAR;
    PG8_BAR;
#undef PG8_SA
#undef PG8_SB
#undef PG8_STAGE
#undef PG8_LDA
#undef PG8_LDB
#undef PG8_MMA
#undef UNIT_PTRS
#undef UNIT_X
}

constexpr int PSTR = 1040;
constexpr int RPB_OFF = 147456;
#define SCHED_FENCE __builtin_amdgcn_sched_barrier(0)
__device__ __forceinline__ void acc8(float (&a)[8], const u32x4 w, const float sgn) {
    a[0] += sgn * bf_lo(w.x); a[1] += sgn * bf_hi(w.x); a[2] += sgn * bf_lo(w.y); a[3] += sgn * bf_hi(w.y);
    a[4] += sgn * bf_lo(w.z); a[5] += sgn * bf_hi(w.z); a[6] += sgn * bf_lo(w.w); a[7] += sgn * bf_hi(w.w);
}
template <int A> __device__ __forceinline__ void pool_a(LAS unsigned char* ldsdst, const bf16_t* Ub, const int pos0, const int S) {
    constexpr int NR = 8 + 2 * A - 1;
    u32x4 rows[NR];
#pragma unroll
    for (int j = 0; j < NR; ++j) { const int pos = pos0 - A + j; const int pc = pos < 0 ? 0 : (pos >= S ? S - 1 : pos); rows[j] = *(const u32x4*)(Ub + (size_t)pc * 512); }
    SCHED_FENCE;
#pragma unroll
    for (int j = 0; j < NR; ++j) { const int pos = pos0 - A + j; if (pos < 0 || pos >= S) rows[j] = (u32x4){0u, 0u, 0u, 0u}; }
    float acc[8];
#pragma unroll
    for (int j = 0; j < 8; ++j) acc[j] = 0.f;
#pragma unroll
    for (int j = 0; j < 2 * A; ++j) acc8(acc, rows[j], 1.0f);
#pragma unroll
    for (int t = 0; t < 8; ++t) {
        const int pos = pos0 + t; const int hi = (pos + A < S) ? pos + A : S, lo = (pos - A > 0) ? pos - A : 0;
        const float inv = 1.0f / (float)(hi - lo);
        const u32x4 cw = rows[A + t];
        float o[8];
        o[0] = acc[0] * inv - bf_lo(cw.x); o[1] = acc[1] * inv - bf_hi(cw.x); o[2] = acc[2] * inv - bf_lo(cw.y); o[3] = acc[3] * inv - bf_hi(cw.y);
        o[4] = acc[4] * inv - bf_lo(cw.z); o[5] = acc[5] * inv - bf_hi(cw.z); o[6] = acc[6] * inv - bf_lo(cw.w); o[7] = acc[7] * inv - bf_hi(cw.w);
        u32x4 w; w.x = cvt_pk_bf16(o[0], o[1]); w.y = cvt_pk_bf16(o[2], o[3]); w.z = cvt_pk_bf16(o[4], o[5]); w.w = cvt_pk_bf16(o[6], o[7]);
        *(LAS u32x4*)(ldsdst + t * PSTR) = w;
        if (t < 7) { acc8(acc, rows[2 * A + t], 1.0f); acc8(acc, rows[t], -1.0f); }
    }
}
__device__ __forceinline__ void mixer_phase(LAS unsigned char* lds, const Params& p, const int G, const int c) {
    const int tid = threadIdx.x, lane = tid & 63, wid = __builtin_amdgcn_readfirstlane(tid >> 6), fr = lane & 15, fq = lane >> 4;
    const bf16_t* aU = (const bf16_t*)(p.ws + WS_ACT); const bf16_t* aGP = aU + ACT_STRIDE; const bf16_t* aQ = aU + 2 * ACT_STRIDE; const bf16_t* aK = aU + 3 * ACT_STRIDE; const bf16_t* aGA = aU + 4 * ACT_STRIDE;
    const bf16_t* VT = (const bf16_t*)(p.ws + WS_VT); const bf16_t* WpT = (const bf16_t*)(p.ws + WS_WP);
    bf16_t* MIX = (bf16_t*)(p.ws + WS_MIX); const float* rsb = (const float*)(p.ws + WS_RS);
    LAS float* rpbs = (LAS float*)(lds + RPB_OFF);
    for (int i = tid; i < 8 * 465; i += 512) rpbs[i] = p.rpb[i];
    __syncthreads();
    for (int it = 0;; ++it) {
        const int L = it * G + c; if (L >= 1280) break;
        const int gr = (L & 7) * 160 + (L >> 3);
        int R, r; if (gr < 1024) { R = 64; r = gr & 63; } else { R = 128; r = (gr - 1024) & 127; }
        const int gr0 = gr - r; const int S = R * 64;
        {
            const int g = wid >> 1, th = wid & 1;
            const int c0 = 128 * g + 8 * fr, tl0 = 32 * th + 8 * fq, pos0 = r * 64 + tl0;
            const bf16_t* Ub = aU + (size_t)gr0 * 64 * 512 + c0;
            LAS unsigned char* dst = lds + (it & 1) * (64 * PSTR) + tl0 * PSTR + c0 * 2;
            if (g == 0) pool_a<1>(dst, Ub, pos0, S); else if (g == 1) pool_a<2>(dst, Ub, pos0, S); else if (g == 2) pool_a<4>(dst, Ub, pos0, S); else pool_a<8>(dst, Ub, pos0, S);
        }
        {
            const int g = wid >> 1, dh = wid & 1;
            bf16x8 bfr[4][4]; u32x2 gw[4][4]; f32x4 psv[4];
            const bf16_t* wb = WpT + (size_t)(g * 128 + 64 * dh + fr) * 128 + 8 * fq;
#pragma unroll
            for (int nt = 0; nt < 4; ++nt)
#pragma unroll
                for (int ks = 0; ks < 4; ++ks) bfr[nt][ks] = *(const bf16x8*)(wb + nt * 16 * 128 + 32 * ks);
            const bf16_t* gb = aGP + ((size_t)gr * 64 + fr) * 512 + 128 * g + 64 * dh + 4 * fq;
#pragma unroll
            for (int mt = 0; mt < 4; ++mt)
#pragma unroll
                for (int nt = 0; nt < 4; ++nt) gw[mt][nt] = *(const u32x2*)(gb + (size_t)mt * 16 * 512 + 16 * nt);
#pragma unroll
            for (int nt = 0; nt < 4; ++nt) psv[nt] = *(const f32x4*)(p.pool_scale + 128 * g + 64 * dh + 16 * nt + 4 * fq);
            float rsm[4];
#pragma unroll
            for (int mt = 0; mt < 4; ++mt) rsm[mt] = rsb[(size_t)gr * 64 + 16 * mt + fr];
            SCHED_FENCE;
            __syncthreads();
            f32x4 acc[4][4];
#pragma unroll
            for (int mt = 0; mt < 4; ++mt)
#pragma unroll
                for (int nt = 0; nt < 4; ++nt) acc[mt][nt] = (f32x4){0.f, 0.f, 0.f, 0.f};
#pragma unroll
            for (int ks = 0; ks < 4; ++ks) {
                bf16x8 af[4];
#pragma unroll
                for (int mt = 0; mt < 4; ++mt) af[mt] = *(const LAS bf16x8*)(lds + (it & 1) * (64 * PSTR) + (16 * mt + fr) * PSTR + (128 * g + 32 * ks + 8 * fq) * 2);
#pragma unroll
                for (int mt = 0; mt < 4; ++mt)
#pragma unroll
                    for (int nt = 0; nt < 4; ++nt) acc[mt][nt] = __builtin_amdgcn_mfma_f32_16x16x32_bf16(bfr[nt][ks], af[mt], acc[mt][nt], 0, 0, 0);
            }
            bf16_t* mb = MIX + ((size_t)gr * 64 + fr) * 1024 + 128 * g + 64 * dh + 4 * fq;
#pragma unroll
            for (int mt = 0; mt < 4; ++mt)
#pragma unroll
                for (int nt = 0; nt < 4; ++nt) {
                    const f32x4 a4 = acc[mt][nt] * rsm[mt]; const u32x2 gg = gw[mt][nt];
                    u32x2 w; w.x = cvt_pk_bf16(a4[0] * psv[nt][0] * bf_lo(gg.x), a4[1] * psv[nt][1] * bf_hi(gg.x)); w.y = cvt_pk_bf16(a4[2] * psv[nt][2] * bf_lo(gg.y), a4[3] * psv[nt][3] * bf_hi(gg.y));
                    *(u32x2*)(mb + (size_t)mt * 16 * 1024 + 16 * nt) = w;
                }
        }
    }
    __syncthreads();
}
constexpr int VREG = 73728;
#define A_BAR() do { SCHED_FENCE; asm volatile("s_waitcnt lgkmcnt(0)" ::: "memory"); __builtin_amdgcn_s_barrier(); SCHED_FENCE; } while (0)
__device__ __forceinline__ void gload16_asm(bf16x8& v, const void* ptr) { asm volatile("global_load_dwordx4 %0, %1, off" : "=v"(v) : "v"(ptr) : "memory"); }
__device__ __forceinline__ void gload4_asm(float& v, const void* ptr) { asm volatile("global_load_dword %0, %1, off" : "=v"(v) : "v"(ptr) : "memory"); }
__device__ __forceinline__ void gload8_asm(u32x2& v, const void* ptr) { asm volatile("global_load_dwordx2 %0, %1, off" : "=v"(v) : "v"(ptr) : "memory"); }
struct AUnit { int gr0, R, r0, h, gA, win; };
__device__ __forceinline__ int win_start(int r, int R) { int s = r - 4; s = s < 0 ? 0 : s; return s > R - 8 ? R - 8 : s; }
__device__ __forceinline__ void attn_decode(int L, int G, AUnit& u) {
    int pp;
    if (G == 256) { const int it = L >> 8, c = L & 255, xcd = c & 7, j = c >> 3; u.h = j & 7; pp = 80 * xcd + 20 * (j >> 3) + it; }
    else { const int xcd = L & 7, q = L >> 3; pp = 80 * xcd + (q >> 3); u.h = q & 7; }
    u.gA = 2 * pp;
    if (u.gA < 1024) { u.R = 64; u.r0 = u.gA & 63; } else { u.R = 128; u.r0 = (u.gA - 1024) & 127; }
    u.gr0 = u.gA - u.r0; u.win = win_start(u.r0, u.R);
}
__device__ __forceinline__ void stage_K(LAS unsigned char* lds, const bf16_t* aK, const AUnit& u, int wid, int lane, int pa) {
    const int rsU = u.win; const int col = 8 * wid + (lane >> 3); const int ch = (lane & 7) ^ ((col >> 1) & 7);
    const bf16_t* src = aK + (size_t)col * 512 + u.h * 64 + ch * 8;
#pragma unroll
    for (int m = 0; m < 9; ++m) { int rw = rsU + m; rw = rw > u.R - 1 ? u.R - 1 : rw;
        if (rw < pa || rw > pa + 8) __builtin_amdgcn_global_load_lds((const unsigned*)(src + (size_t)(u.gr0 + rw) * 64 * 512), (LAS unsigned*)(lds + (wid + 8 * (rw % 9)) * 1024), 16, 0, 0); }
}
__device__ __forceinline__ void stage_V(LAS unsigned char* lds, const bf16_t* VT, const AUnit& u, int wid, int lane, int pa) {
    const int rsU = u.win; const int d = 8 * wid + (lane >> 3); const int ch = (lane & 7) ^ ((d >> 1) & 7);
    const bf16_t* src = VT + (size_t)u.h * 4096 + d * 64 + ch * 8;
#pragma unroll
    for (int m = 0; m < 9; ++m) { int rw = rsU + m; rw = rw > u.R - 1 ? u.R - 1 : rw;
        if (rw < pa || rw > pa + 8) __builtin_amdgcn_global_load_lds((const unsigned*)(src + (size_t)(u.gr0 + rw) * 8 * 4096), (LAS unsigned*)(lds + VREG + (wid + 8 * (rw % 9)) * 1024), 16, 0, 0); }
}
__device__ __forceinline__ void attn_phase(LAS unsigned char* lds, const Params& p, const int G, const int c) {
    const int tid = threadIdx.x, lane = tid & 63, wid = __builtin_amdgcn_readfirstlane(tid >> 6), fr = lane & 15, fq = lane >> 4;
    const bf16_t* aU = (const bf16_t*)(p.ws + WS_ACT); const bf16_t* aQ = aU + 2 * ACT_STRIDE; const bf16_t* aK = aU + 3 * ACT_STRIDE; const bf16_t* aGA = aU + 4 * ACT_STRIDE;
    const bf16_t* VT = (const bf16_t*)(p.ws + WS_VT);
    bf16_t* MIX = (bf16_t*)(p.ws + WS_MIX); const float* rsb = (const float*)(p.ws + WS_RS);
    const LAS float* rpbs = (const LAS float*)(lds + RPB_OFF);
    const int sel = wid >> 2, qb = wid & 3;
    const int ws_ = (qb == 0) ? 0 : (qb == 1) ? 8 : (qb == 2) ? 24 : 32;
    int kofs[2][2], vofs[4];
#pragma unroll
    for (int t = 0; t < 2; ++t) { const int kc = ws_ + 8 * (fr >> 2) + 4 * t + (fr & 3); const int sw = (kc >> 1) & 7; kofs[t][0] = kc * 128 + ((fq ^ sw) << 4); kofs[t][1] = kc * 128 + (((fq | 4) ^ sw) << 4); }
#pragma unroll
    for (int dt = 0; dt < 4; ++dt) { const int d = 16 * dt + fr; vofs[dt] = VREG + d * 128 + ((((ws_ >> 3) + fq) ^ ((d >> 1) & 7)) << 4); }
    const int cq = 16 * qb + fr; int cs = cq - 8; cs = cs < 0 ? 0 : cs; cs = cs > 48 ? 48 : cs;
    int L = c; if (L >= 5120) return;
    if (wid >= 4) __builtin_amdgcn_s_setprio(1);
    AUnit cur, nxt; attn_decode(L, G, cur);
    stage_K(lds, aK, cur, wid, lane, -100);
    int pgr0 = -1, pwin = 0;
    size_t qtok = (size_t)(cur.gA + sel) * 64 + 16 * qb + fr;
    bf16x8 qf0, qf1; u32x2 gw[4];
    SCHED_FENCE;
    gload16_asm(qf0, aQ + qtok * 512 + cur.h * 64 + 8 * fq); gload16_asm(qf1, aQ + qtok * 512 + cur.h * 64 + 32 + 8 * fq);
#pragma unroll
    for (int dt = 0; dt < 4; ++dt) gload8_asm(gw[dt], aGA + qtok * 512 + cur.h * 64 + 16 * dt + 4 * fq);
    float rsq; gload4_asm(rsq, rsb + qtok);
    SCHED_FENCE;
    SCHED_FENCE; asm volatile("s_waitcnt vmcnt(0)" ::: "memory"); SCHED_FENCE;
    for (;;) {
        const int r = cur.r0 + sel; const int rs0 = win_start(r, cur.R); const int sb = rs0 % 9;
        const LAS float* rb = rpbs + cur.h * 465 + (rs0 - r + 7) * 31;
        const int h = cur.h;
        SCHED_FENCE; asm volatile("s_waitcnt vmcnt(4) lgkmcnt(0)" ::: "memory"); __builtin_amdgcn_s_barrier(); SCHED_FENCE;
        asm volatile("" : "+v"(qf0), "+v"(qf1)); SCHED_FENCE;
        stage_V(lds, VT, cur, wid, lane, (pgr0 == cur.gr0) ? pwin : -100);
        pgr0 = cur.gr0; pwin = cur.win;
        SCHED_FENCE;
        const int Ln = L + G; const bool has_next = Ln < 5120;
        nxt = cur; if (has_next) attn_decode(Ln, G, nxt);
        const size_t qtok_n = (size_t)(nxt.gA + sel) * 64 + 16 * qb + fr;
        bf16x8 qn0, qn1; u32x2 gn[4];
        gload16_asm(qn0, aQ + qtok_n * 512 + nxt.h * 64 + 8 * fq); gload16_asm(qn1, aQ + qtok_n * 512 + nxt.h * 64 + 32 + 8 * fq);
#pragma unroll
        for (int dt = 0; dt < 4; ++dt) gload8_asm(gn[dt], aGA + qtok_n * 512 + nxt.h * 64 + 16 * dt + 4 * fq);
        float rsn; gload4_asm(rsn, rsb + qtok_n);
        SCHED_FENCE;
        f32x4 s[8][2];
        {
            const LAS unsigned char* kb = lds;
#pragma unroll
            for (int i = 0; i < 8; ++i)
#pragma unroll
                for (int t = 0; t < 2; ++t) {
                    const int so = ((sb + i >= 9) ? sb + i - 9 : sb + i) * 8192;
                    const bf16x8 k0 = *(const LAS bf16x8*)(kb + kofs[t][0] + so), k1 = *(const LAS bf16x8*)(kb + kofs[t][1] + so);
                    f32x4 z = (f32x4){0.f, 0.f, 0.f, 0.f};
                    z = __builtin_amdgcn_mfma_f32_16x16x32_bf16(k0, qf0, z, 0, 0, 0);
                    z = __builtin_amdgcn_mfma_f32_16x16x32_bf16(k1, qf1, z, 0, 0, 0);
                    s[i][t] = z;
                }
        }
        typedef float f32x2 __attribute__((ext_vector_type(2)));
        f32x2 sv[8][2][2];
        float mx = -1e30f;
#pragma unroll
        for (int t = 0; t < 2; ++t)
#pragma unroll
            for (int jp = 0; jp < 2; ++jp) {
                f32x2 mk1, mk2; int bi2[2];
#pragma unroll
                for (int e = 0; e < 2; ++e) { const int j = 2 * jp + e; const int kc = ws_ + 8 * fq + 4 * t + j; const bool valid = (kc >= cs) && (kc < cs + 16);
                    int bi = kc - cq + 15; bi = bi < 0 ? 0 : bi; bi = bi > 30 ? 30 : bi; bi2[e] = bi; mk1[e] = valid ? 1.0f : 0.0f; mk2[e] = valid ? 0.0f : -1e30f; }
#pragma unroll
                for (int i = 0; i < 8; ++i) { f32x2 bb; bb.x = rb[i * 31 + bi2[0]]; bb.y = rb[i * 31 + bi2[1]];
                    f32x2 x; x.x = s[i][t][2 * jp]; x.y = s[i][t][2 * jp + 1];
                    const f32x2 v = (x + bb) * mk1 + mk2; sv[i][t][jp] = v; mx = fmaxf(mx, fmaxf(v.x, v.y)); }
            }
        mx = xmax4(mx);
        const float mxl = mx * 1.44269504f;
        const f32x2 c2 = (f32x2){1.44269504f, 1.44269504f}, m2 = (f32x2){-mxl, -mxl};
        f32x2 sum2 = (f32x2){0.f, 0.f};
#pragma unroll
        for (int i = 0; i < 8; ++i)
#pragma unroll
            for (int t = 0; t < 2; ++t)
#pragma unroll
                for (int jp = 0; jp < 2; ++jp) { const f32x2 a2 = sv[i][t][jp] * c2 + m2; f32x2 e; e.x = __builtin_amdgcn_exp2f(a2.x); e.y = __builtin_amdgcn_exp2f(a2.y);
                    s[i][t][2 * jp] = e.x; s[i][t][2 * jp + 1] = e.y; sum2 += e; }
        float sum = sum2.x + sum2.y;
        sum = xsum4(sum);
        const float inv0 = 1.0f / sum;
        bf16x8 pf[8];
#pragma unroll
        for (int i = 0; i < 8; ++i) {
            u32x4 pw; pw.x = cvt_pk_bf16(s[i][0][0], s[i][0][1]); pw.y = cvt_pk_bf16(s[i][0][2], s[i][0][3]);
            pw.z = cvt_pk_bf16(s[i][1][0], s[i][1][1]); pw.w = cvt_pk_bf16(s[i][1][2], s[i][1][3]);
            pf[i] = __builtin_bit_cast(bf16x8, pw);
        }
        SCHED_FENCE; asm volatile("s_waitcnt vmcnt(0) lgkmcnt(0)" ::: "memory"); __builtin_amdgcn_s_barrier(); SCHED_FENCE;
        stage_K(lds, aK, nxt, wid, lane, (nxt.gr0 == cur.gr0) ? cur.win : -100);
        SCHED_FENCE;
        asm volatile("" : "+v"(qn0), "+v"(qn1), "+v"(gn[0]), "+v"(gn[1]), "+v"(gn[2]), "+v"(gn[3]), "+v"(gw[0]), "+v"(gw[1]), "+v"(gw[2]), "+v"(gw[3]), "+v"(rsn), "+v"(rsq)); SCHED_FENCE;
        f32x4 o[4];
#pragma unroll
        for (int dt = 0; dt < 4; ++dt) o[dt] = (f32x4){0.f, 0.f, 0.f, 0.f};
        {
            const LAS unsigned char* vb = lds;
#pragma unroll
            for (int i = 0; i < 8; ++i)
#pragma unroll
                for (int dt = 0; dt < 4; ++dt) { const int so = ((sb + i >= 9) ? sb + i - 9 : sb + i) * 8192;
                    const bf16x8 vf = *(const LAS bf16x8*)(vb + vofs[dt] + so); o[dt] = __builtin_amdgcn_mfma_f32_16x16x32_bf16(vf, pf[i], o[dt], 0, 0, 0); }
        }
#pragma unroll
        for (int dt = 0; dt < 4; ++dt) {
            const int chn = h * 64 + 16 * dt + 4 * fq;
            const float inv = inv0 * rsq;
            u32x2 w; w.x = cvt_pk_bf16(o[dt][0] * inv * bf_lo(gw[dt].x), o[dt][1] * inv * bf_hi(gw[dt].x)); w.y = cvt_pk_bf16(o[dt][2] * inv * bf_lo(gw[dt].y), o[dt][3] * inv * bf_hi(gw[dt].y));
            *(u32x2*)(MIX + qtok * 1024 + 512 + chn) = w;
        }
        if (!has_next) break;
        cur = nxt; L = Ln; qtok = qtok_n; qf0 = qn0; qf1 = qn1; rsq = rsn;
#pragma unroll
        for (int dt = 0; dt < 4; ++dt) gw[dt] = gn[dt];
    }
    asm volatile("s_waitcnt vmcnt(0)" ::: "memory"); __builtin_amdgcn_s_barrier();
    __builtin_amdgcn_s_setprio(0);
}


}
__global__ void __launch_bounds__(512, 2) fwd_kernel(Params p) {
    extern __shared__ __attribute__((aligned(16))) unsigned char shm[];
    LAS unsigned char* lds = (LAS unsigned char*)shm;
    const int G = gridDim.x, c = blockIdx.x;
    cg::grid_group grid = cg::this_grid();
#ifndef REP0
#define REP0 1
#endif
#ifndef REP1
#define REP1 1
#endif
#ifndef REP2
#define REP2 1
#endif
#ifndef REP3
#define REP3 1
#endif
    volatile LAS unsigned* bst = (volatile LAS unsigned*)(lds + 147456 + 8 * 465 * 4);
    if (threadIdx.x < 2) bst[threadIdx.x] = 0u;
    __syncthreads();
    XcdBarrier xbar = xcd_barrier_post((unsigned*)(p.ws + WS_BAR), bst);
#define GRID_SYNC() do { if (p.coop) { if (p.use_cg) grid.sync(); else xcd_barrier(xbar); } } while (0)
    if (p.ph_lo <= 0 && 0 < p.ph_hi) { for (int rep = 0; rep < REP0; ++rep) { prep_phase(p, G); GRID_SYNC(); } }
    if (p.ph_lo <= 1 && 1 < p.ph_hi) { for (int rep = 0; rep < REP1; ++rep) { gemm_phase<0>(lds, p, G, c); GRID_SYNC(); } }
    if (p.ph_lo <= 2 && 2 < p.ph_hi) { for (int rep = 0; rep < REP2; ++rep) { mixer_phase(lds, p, G, c); attn_phase(lds, p, G, c); GRID_SYNC(); } }
    if (p.ph_lo <= 3 && 3 < p.ph_hi) { for (int rep = 0; rep < REP3; ++rep) { gemm_phase<1>(lds, p, G, c); if (REP3 > 1 && p.coop) grid.sync(); } }
}

#ifndef N_LAUNCHES
#define N_LAUNCHES 1
#endif

extern "C" void kernel_launch(void* const* d_in, const int* in_sizes, int n_in, void* d_out, int out_size, void* d_ws, size_t ws_size, hipStream_t stream) {
    static int grid = 0;
    if (grid == 0) {
        if (n_in != 10 || ws_size < WS_END) { fprintf(stderr, "kernel_launch: unexpected inputs (n_in %d, ws %zu < %zu)\n", n_in, ws_size, (size_t)WS_END); grid = -1; return; }
        int dev = 0, cus = 0, per_cu = 0;
        (void)hipGetDevice(&dev); (void)hipDeviceGetAttribute(&cus, hipDeviceAttributeMultiprocessorCount, dev);
        if (hipFuncSetAttribute((const void*)fwd_kernel, hipFuncAttributeMaxDynamicSharedMemorySize, LDS_BYTES) != hipSuccess) { fprintf(stderr, "kernel_launch: hipFuncSetAttribute failed\n"); grid = -1; return; }
        (void)hipOccupancyMaxActiveBlocksPerMultiprocessor(&per_cu, (const void*)fwd_kernel, 512, LDS_BYTES);
        (void)hipGetLastError();
        if (per_cu < 1) per_cu = 1;
        grid = cus;
    }
    if (grid < 0) return;
    Params p{};
    p.xp = (const float*)d_in[0]; p.xs = (const float*)d_in[1]; p.norm_g = (const float*)d_in[2]; p.w_in = (const float*)d_in[3]; p.w_pool = (const float*)d_in[4];
    p.pool_scale = (const float*)d_in[5]; p.qg = (const float*)d_in[6]; p.kg = (const float*)d_in[7]; p.rpb = (const float*)d_in[8]; p.w_out = (const float*)d_in[9];
    p.out = (float*)d_out; p.ws = (unsigned char*)d_ws; p.use_cg = 0;
    (void)hipMemsetAsync((char*)d_ws + WS_BAR, 0, XCD_BAR_WORDS * 4, stream);
#if N_LAUNCHES == 1
    p.ph_lo = 0; p.ph_hi = 4; p.coop = 1;
    void* args[] = {&p};
    hipError_t e = hipLaunchCooperativeKernel((const void*)fwd_kernel, dim3(grid), dim3(512), args, LDS_BYTES, stream);
    if (e != hipSuccess) fprintf(stderr, "cooperative launch failed: %s (grid %d)\n", hipGetErrorString(e), grid);
#else
    for (int ph = 0; ph < 4; ++ph) { p.ph_lo = ph; p.ph_hi = ph + 1; p.coop = 0; hipLaunchKernelGGL(fwd_kernel, dim3(grid), dim3(512), LDS_BYTES, stream, p); }
#endif
}
```

```cpp
#include <hip/hip_runtime.h>
#include <hip/hip_cooperative_groups.h>
#include <cstdio>
namespace cg = cooperative_groups;

#define LAS __attribute__((address_space(3)))
typedef unsigned short bf16_t;
typedef short bf16x8 __attribute__((ext_vector_type(8)));
typedef float f32x4 __attribute__((ext_vector_type(4)));
typedef unsigned u32x4 __attribute__((ext_vector_type(4)));
typedef unsigned u32x2 __attribute__((ext_vector_type(2)));

namespace {
constexpr int NTOK = 81920, NTOK_P = 65536;
constexpr float EPS = 1e-6f;
constexpr int BM = 256, BK = 64, HALF = 128, HTB = HALF * BK * 2, STAGE_BYTES = 8 * HTB;
constexpr int LDS_BYTES = 147456 + 8 * 465 * 4 + 16;
constexpr size_t ACT_STRIDE = (size_t)NTOK * 512;
constexpr size_t WS_XB = 0;
constexpr size_t WS_RS = WS_XB + (size_t)NTOK * 1024 * 2;
constexpr size_t WS_WIN = WS_RS + (size_t)NTOK * 4;
constexpr size_t WS_WOUT = WS_WIN + (size_t)3072 * 1024 * 2;
constexpr size_t WS_WP = WS_WOUT + (size_t)1024 * 1024 * 2;
constexpr size_t WS_ACT = WS_WP + (size_t)4 * 128 * 128 * 2;
constexpr size_t WS_VT = WS_ACT + 5 * ACT_STRIDE * 2;
constexpr size_t WS_MIX = WS_VT + ACT_STRIDE * 2;
constexpr size_t WS_RSI = WS_MIX + (size_t)NTOK * 1024 * 2;
constexpr size_t WS_ID = WS_RSI + (size_t)NTOK * 4;
constexpr size_t WS_BAR = WS_ID + (size_t)256 * 1024 * 2;
constexpr size_t WS_END = WS_BAR + 16384;

struct Params {
    const float* xp; const float* xs; const float* norm_g; const float* w_in; const float* w_pool; const float* pool_scale;
    const float* qg; const float* kg; const float* rpb; const float* w_out; float* out; unsigned char* ws;
    int ph_lo, ph_hi, coop, use_cg;
};
#define XB_TMO      128
#define XB_XCNT(j)  (256  + 64 * (j))
#define XB_XSUB(j)  (1280 + 64 * (j))
#define XB_XGEN(j)  (2304 + 64 * (j))
#define XB_TOP      3328
#define XB_TOPGEN   3392
#define XCD_BAR_WORDS 3456
#define XB_SPIN_CAP (1u << 22)
__device__ __forceinline__ unsigned xb_ld(unsigned* p)              { return __hip_atomic_load(p, __ATOMIC_RELAXED, __HIP_MEMORY_SCOPE_AGENT); }
__device__ __forceinline__ unsigned xb_add(unsigned* p, unsigned v) { return __hip_atomic_fetch_add(p, v, __ATOMIC_RELAXED, __HIP_MEMORY_SCOPE_AGENT); }
__device__ __forceinline__ unsigned xb_xcc_id() { return (unsigned)__builtin_amdgcn_s_getreg((3 << 11) | 20) & 0xFu; }
#define XB_SPIN(cond, bar) do { unsigned _sp = 0; while (cond) { __builtin_amdgcn_s_sleep(1); \
    if ((++_sp & 255u) == 0u) { if (xb_ld(&(bar)[XB_TMO])) break; if (_sp > XB_SPIN_CAP) { atomicAdd(&(bar)[XB_TMO], 1u); break; } } } } while (0)
struct XcdBarrier { unsigned* bar; unsigned x; volatile LAS unsigned* st; };
__device__ __forceinline__ XcdBarrier xcd_barrier_post(unsigned* bar, volatile LAS unsigned* st) {
    XcdBarrier b; b.bar = bar; b.x = xb_xcc_id(); b.st = st;
    if (threadIdx.x == 0) (void)xb_add(&bar[XB_XCNT(b.x)], 1u);
    return b;
}
__device__ __forceinline__ void xcd_barrier_complete(unsigned* bar, unsigned x, unsigned& nloc, unsigned& nx) {
    const unsigned G = gridDim.x * gridDim.y * gridDim.z;
    unsigned sum, cnt, mine, sp = 0u;
    for (;;) {
        sum = 0u; cnt = 0u; mine = 0u;
#pragma unroll
        for (unsigned j = 0; j < 16; ++j) { const unsigned c = xb_ld(&bar[XB_XCNT(j)]); sum += c; cnt += (c > 0u) ? 1u : 0u; mine = (j == x) ? c : mine; }
        if (sum == G) break;
        __builtin_amdgcn_s_sleep(1);
        if ((++sp & 255u) == 0u) { if (xb_ld(&bar[XB_TMO])) break; if (sp > XB_SPIN_CAP) { atomicAdd(&bar[XB_TMO], 1u); break; } }
    }
    nloc = mine > 0u ? mine : 1u; nx = cnt > 0u ? cnt : 1u;
}
__device__ __forceinline__ void xcd_barrier(const XcdBarrier& b) {
    asm volatile("s_waitcnt vmcnt(0) lgkmcnt(0)" ::: "memory");
    __syncthreads();
    if (threadIdx.x == 0) {
        unsigned* bar = b.bar;
        __builtin_amdgcn_s_waitcnt(0);
        unsigned nloc = b.st[0], nx = b.st[1];
        if (nloc == 0u) { xcd_barrier_complete(bar, b.x, nloc, nx); b.st[0] = nloc; b.st[1] = nx; }
        const unsigned old = xb_add(&bar[XB_XSUB(b.x)], 1u);
        const unsigned gen = old / nloc;
        if (old + 1u == (gen + 1u) * nloc) {
            __builtin_amdgcn_fence(__ATOMIC_RELEASE, "agent");
            asm volatile("s_waitcnt vmcnt(0)" ::: "memory");
            const unsigned og = xb_add(&bar[XB_TOP], 1u);
            const unsigned tg = og / nx;
            if (og + 1u == (tg + 1u) * nx) xb_add(&bar[XB_TOPGEN], 1u);
            else XB_SPIN(xb_ld(&bar[XB_TOPGEN]) == tg, bar);
            __builtin_amdgcn_fence(__ATOMIC_ACQUIRE, "agent");
            xb_add(&bar[XB_XGEN(b.x)], 1u);
            asm volatile("s_waitcnt vmcnt(0)" ::: "memory");
        } else {
            XB_SPIN(xb_ld(&bar[XB_XGEN(b.x)]) == gen, bar);
            __builtin_amdgcn_fence(__ATOMIC_ACQUIRE, "agent");
            asm volatile("s_waitcnt vmcnt(0)" ::: "memory");
        }
    }
    __syncthreads();
}

__device__ __forceinline__ unsigned cvt_pk_bf16(float lo, float hi) { unsigned r; asm("v_cvt_pk_bf16_f32 %0, %1, %2" : "=v"(r) : "v"(lo), "v"(hi)); return r; }
__device__ __forceinline__ float bf_lo(unsigned w) { return __uint_as_float(w << 16); }
__device__ __forceinline__ float bf_hi(unsigned w) { return __uint_as_float(w & 0xffff0000u); }
typedef unsigned xr_u2 __attribute__((ext_vector_type(2)));
__device__ __forceinline__ float xsum4(float x) {
    xr_u2 r = __builtin_amdgcn_permlane32_swap(__float_as_uint(x), __float_as_uint(x), false, false); const float s = __uint_as_float(r.x) + __uint_as_float(r.y);
    xr_u2 q = __builtin_amdgcn_permlane16_swap(__float_as_uint(s), __float_as_uint(s), false, false); return __uint_as_float(q.x) + __uint_as_float(q.y);
}
__device__ __forceinline__ float xmax4(float x) {
    xr_u2 r = __builtin_amdgcn_permlane32_swap(__float_as_uint(x), __float_as_uint(x), false, false); const float s = fmaxf(__uint_as_float(r.x), __uint_as_float(r.y));
    xr_u2 q = __builtin_amdgcn_permlane16_swap(__float_as_uint(s), __float_as_uint(s), false, false); return fmaxf(__uint_as_float(q.x), __uint_as_float(q.y));
}
__device__ __forceinline__ float silu_f(float v) { return v * __builtin_amdgcn_rcpf(1.0f + __expf(-v)); }

__device__ __forceinline__ int lds_byte(int r, int c) { const int st = (r >> 4) * 2 + (c >> 5), rr = r & 15, cc = c & 31, ob = rr * 64 + cc * 2; return st * 1024 + (ob ^ (((ob >> 9) & 1) << 5)); }
__device__ __forceinline__ void stage_rc(int b, int& R, int& C) { const int st = b / 1024, sb = b % 1024, swz = sb ^ (((sb >> 9) & 1) << 5); R = (st >> 1) * 16 + swz / 64; C = (st & 1) * 32 + (swz % 64) / 2; }
__device__ __forceinline__ int perm32(int rho) { const int n = rho >> 4, i = rho & 15; return 8 * (i >> 2) + 4 * n + (i & 3); }

struct Unit { int pm, pn; };
template <int nM, int nN> __device__ __forceinline__ bool unit_next(int i, int G, int c, Unit& u) {
    constexpr int nwg = nM * nN; const long L = (long)i * G + c; if (L >= nwg) return false;
    int wgid = (int)L; { constexpr int q = nwg / 8, r = nwg % 8; const int xcd = wgid % 8, off = wgid / 8; wgid = (xcd < r ? xcd * (q + 1) : r * (q + 1) + (xcd - r) * q) + off; }
    constexpr int nig = 8 * nN; const int gid = wgid / nig, fm = gid * 8, gsz = (nM - fm) < 8 ? (nM - fm) : 8;
    u.pm = fm + ((wgid % nig) % gsz); u.pn = (wgid % nig) / gsz; return true;
}

__device__ __forceinline__ void prep_phase(const Params& p, int G) {
    const int tid = threadIdx.x, lane = tid & 63, wid = tid >> 6;
    bf16_t* xb = (bf16_t*)(p.ws + WS_XB); float* rsb = (float*)(p.ws + WS_RS); float* rsib = (float*)(p.ws + WS_RSI);
    const int nw = G * 8;
#define PREP_LOAD(dst, row) do { const float* _xr = ((row) < NTOK_P) ? p.xp + (size_t)(row) * 1024 : p.xs + (size_t)((row) - NTOK_P) * 1024; \
        dst[0] = __builtin_nontemporal_load((const f32x4*)(_xr + lane * 8)); dst[1] = __builtin_nontemporal_load((const f32x4*)(_xr + lane * 8 + 4)); \
        dst[2] = __builtin_nontemporal_load((const f32x4*)(_xr + 512 + lane * 8)); dst[3] = __builtin_nontemporal_load((const f32x4*)(_xr + 512 + lane * 8 + 4)); } while (0)
#define PREP_DO(v, row) do { float ss = 0.f; \
        _Pragma("unroll") for (int k = 0; k < 4; ++k) _Pragma("unroll") for (int j = 0; j < 4; ++j) ss += v[k][j] * v[k][j]; \
        _Pragma("unroll") for (int o = 32; o >= 1; o >>= 1) ss += __shfl_xor(ss, o); \
        const float rsc = rsqrtf(ss * (1.0f / 1024.0f) + EPS); u32x4 w0, w1; if (lane == 0) { rsb[row] = rsc; rsib[row] = sqrtf(ss * (1.0f / 1024.0f) + EPS); } \
        w0.x = cvt_pk_bf16(v[0][0] * rsc, v[0][1] * rsc); w0.y = cvt_pk_bf16(v[0][2] * rsc, v[0][3] * rsc); w0.z = cvt_pk_bf16(v[1][0] * rsc, v[1][1] * rsc); w0.w = cvt_pk_bf16(v[1][2] * rsc, v[1][3] * rsc); \
        w1.x = cvt_pk_bf16(v[2][0] * rsc, v[2][1] * rsc); w1.y = cvt_pk_bf16(v[2][2] * rsc, v[2][3] * rsc); w1.z = cvt_pk_bf16(v[3][0] * rsc, v[3][1] * rsc); w1.w = cvt_pk_bf16(v[3][2] * rsc, v[3][3] * rsc); \
        *(u32x4*)(xb + (size_t)(row) * 1024 + lane * 8) = w0; *(u32x4*)(xb + (size_t)(row) * 1024 + 512 + lane * 8) = w1; } while (0)
    {
        int row = blockIdx.x * 8 + wid;
        f32x4 va[4], vb[4], vc[4];
        if (row < NTOK) PREP_LOAD(va, row);
        if (row + nw < NTOK) PREP_LOAD(vb, row + nw);
        for (; row < NTOK; row += 3 * nw) {
            if (row + 2 * nw < NTOK) PREP_LOAD(vc, row + 2 * nw);
            PREP_DO(va, row);
            if (row + nw < NTOK) { if (row + 3 * nw < NTOK) PREP_LOAD(va, row + 3 * nw); PREP_DO(vb, row + nw); }
            if (row + 2 * nw < NTOK) { if (row + 4 * nw < NTOK) PREP_LOAD(vb, row + 4 * nw); PREP_DO(vc, row + 2 * nw); }
        }
    }
#undef PREP_LOAD
#undef PREP_DO
    const int gt = blockIdx.x * 512 + tid, T = G * 512;
    bf16_t* WinT = (bf16_t*)(p.ws + WS_WIN); bf16_t* WoutT = (bf16_t*)(p.ws + WS_WOUT); bf16_t* WpT = (bf16_t*)(p.ws + WS_WP);
    for (int idx = gt; idx < 3072 * 128; idx += T) {
        const int n = idx % 3072, k8 = idx / 3072; float v[8];
#pragma unroll
        for (int j = 0; j < 8; ++j) v[j] = p.w_in[(size_t)(k8 * 8 + j) * 3072 + n] * p.norm_g[k8 * 8 + j];
        u32x4 w; w.x = cvt_pk_bf16(v[0], v[1]); w.y = cvt_pk_bf16(v[2], v[3]); w.z = cvt_pk_bf16(v[4], v[5]); w.w = cvt_pk_bf16(v[6], v[7]);
        *(u32x4*)(WinT + (size_t)n * 1024 + k8 * 8) = w;
    }
    for (int idx = gt; idx < 1024 * 128; idx += T) {
        const int n = idx % 1024, k8 = idx / 1024; float v[8];
#pragma unroll
        for (int j = 0; j < 8; ++j) v[j] = p.w_out[(size_t)(k8 * 8 + j) * 1024 + n];
        u32x4 w; w.x = cvt_pk_bf16(v[0], v[1]); w.y = cvt_pk_bf16(v[2], v[3]); w.z = cvt_pk_bf16(v[4], v[5]); w.w = cvt_pk_bf16(v[6], v[7]);
        *(u32x4*)(WoutT + (size_t)n * 1024 + k8 * 8) = w;
    }
    for (int idx = gt; idx < 256 * 128; idx += T) {
        const int n = idx >> 7, k8 = idx & 127; u32x4 w = (u32x4){0u, 0u, 0u, 0u};
        if (k8 == (n >> 3)) { const unsigned one = 0x3F80u << (16 * (n & 1)); const int wd = (n & 7) >> 1; w.x = wd == 0 ? one : 0u; w.y = wd == 1 ? one : 0u; w.z = wd == 2 ? one : 0u; w.w = wd == 3 ? one : 0u; }
        *(u32x4*)((bf16_t*)(p.ws + WS_ID) + (size_t)n * 1024 + k8 * 8) = w;
    }
    for (int idx = gt; idx < 4 * 128 * 16; idx += T) {
        const int d = idx % 128, c8 = (idx / 128) % 16, g = idx / 2048; float v[8];
#pragma unroll
        for (int j = 0; j < 8; ++j) v[j] = p.w_pool[(size_t)(g * 128 + c8 * 8 + j) * 128 + d];
        u32x4 w; w.x = cvt_pk_bf16(v[0], v[1]); w.y = cvt_pk_bf16(v[2], v[3]); w.z = cvt_pk_bf16(v[4], v[5]); w.w = cvt_pk_bf16(v[6], v[7]);
        *(u32x4*)(WpT + (size_t)(g * 128 + d) * 128 + c8 * 8) = w;
    }
}

__device__ __forceinline__ void epi_gemm1(const f32x4 (&acc)[2][2][4][2], const Unit& u, int wr, int wc, int fr, int fq, const Params& p) {
    if (u.pn == 8 || u.pn == 9) {
        bf16_t* VT = (bf16_t*)(p.ws + WS_VT);
        const int gr = u.pm * 4 + wc;
#pragma unroll
        for (int ai = 0; ai < 2; ++ai)
#pragma unroll
            for (int m = 0; m < 4; ++m) {
                const int vc = (u.pn - 8) * 256 + ai * 128 + wr * 64 + m * 16 + fr; const int h = vc >> 6, d = vc & 63;
                bf16_t* dst = VT + ((size_t)(gr * 8 + h) * 64 + d) * 64 + fq * 8;
#pragma unroll
                for (int bj = 0; bj < 2; ++bj) { const f32x4 v0 = acc[ai][bj][m][0], v1 = acc[ai][bj][m][1];
                    u32x4 w; w.x = cvt_pk_bf16(v0[0], v0[1]); w.y = cvt_pk_bf16(v0[2], v0[3]); w.z = cvt_pk_bf16(v1[0], v1[1]); w.w = cvt_pk_bf16(v1[2], v1[3]);
                    __builtin_nontemporal_store(w, (u32x4*)(dst + 32 * bj)); }
            }
    } else {
        const int kind = u.pn < 8 ? (u.pn >> 1) : 4;
        bf16_t* base = (bf16_t*)(p.ws + WS_ACT) + (size_t)kind * ACT_STRIDE;
        const int row0 = u.pm * 256 + wr * 64 + fr, col0 = (u.pn & 1) * 256 + wc * 64 + fq * 8;
        f32x4 gv[2][2];
        if (kind == 2 || kind == 3) { const float* g = kind == 2 ? p.qg : p.kg; const float sc = kind == 2 ? 0.125f : 1.0f;
#pragma unroll
            for (int bj = 0; bj < 2; ++bj)
#pragma unroll
                for (int n = 0; n < 2; ++n) gv[bj][n] = *(const f32x4*)(g + 32 * bj + 8 * fq + 4 * n) * sc; }
#pragma unroll
        for (int ai = 0; ai < 2; ++ai)
#pragma unroll
            for (int m = 0; m < 4; ++m) {
                const int row = row0 + ai * 128 + m * 16;
                f32x4 v[2][2];
#pragma unroll
                for (int bj = 0; bj < 2; ++bj)
#pragma unroll
                    for (int n = 0; n < 2; ++n) v[bj][n] = acc[ai][bj][m][n];
                if (kind == 2 || kind == 3) {
                    float ss = 0.f;
#pragma unroll
                    for (int bj = 0; bj < 2; ++bj)
#pragma unroll
                        for (int n = 0; n < 2; ++n) { const f32x4 x = v[bj][n]; ss += (x[0] * x[0] + x[1] * x[1]) + (x[2] * x[2] + x[3] * x[3]); }
                    ss = xsum4(ss);
                    const float sc = rsqrtf(ss * (1.0f / 64.0f) + EPS);
#pragma unroll
                    for (int bj = 0; bj < 2; ++bj)
#pragma unroll
                        for (int n = 0; n < 2; ++n) v[bj][n] = v[bj][n] * gv[bj][n] * sc;
                } else if (kind == 1 || kind == 4) {
#pragma unroll
                    for (int bj = 0; bj < 2; ++bj)
#pragma unroll
                        for (int n = 0; n < 2; ++n)
#pragma unroll
                            for (int j = 0; j < 4; ++j) v[bj][n][j] = silu_f(v[bj][n][j]);
                }
                bf16_t* dst = base + (size_t)row * 512 + col0;
#pragma unroll
                for (int bj = 0; bj < 2; ++bj) { u32x4 w; w.x = cvt_pk_bf16(v[bj][0][0], v[bj][0][1]); w.y = cvt_pk_bf16(v[bj][0][2], v[bj][0][3]); w.z = cvt_pk_bf16(v[bj][1][0], v[bj][1][1]); w.w = cvt_pk_bf16(v[bj][1][2], v[bj][1][3]);
                    __builtin_nontemporal_store(w, (u32x4*)(dst + 32 * bj)); }
            }
    }
}
__device__ __forceinline__ void epi_gemm2(const f32x4 (&acc)[2][2][4][2], const Unit& u, int wr, int wc, int fr, int fq, const Params& p) {
    const int row0 = u.pm * 256 + wr * 64 + fr, col0 = u.pn * 256 + wc * 32 + 4 * fq;
    const float* rsi = (const float*)(p.ws + WS_RSI) + row0; float ri[2][4];
#pragma unroll
    for (int ai = 0; ai < 2; ++ai)
#pragma unroll
        for (int m = 0; m < 4; ++m) ri[ai][m] = rsi[ai * 128 + m * 16];
#pragma unroll
    for (int ai = 0; ai < 2; ++ai)
#pragma unroll
        for (int m = 0; m < 4; ++m) {
            const int row = row0 + ai * 128 + m * 16;
            float* orow = p.out + (size_t)row * 1024 + col0;
#pragma unroll
            for (int bj = 0; bj < 2; ++bj)
#pragma unroll
                for (int n = 0; n < 2; ++n) *(f32x4*)(orow + bj * 128 + n * 16) = acc[ai][bj][m][n] * ri[ai][m];
        }
}

template <int MODE> __device__ __forceinline__ void acc_init(f32x4 (&acc)[2][2][4][2], const Unit& u, int wr, int wc, int fr, int fq, const Params& p) {
    if (MODE == 0) {
#pragma unroll
        for (int a = 0; a < 2; ++a)
#pragma unroll
            for (int b = 0; b < 2; ++b)
#pragma unroll
                for (int m = 0; m < 4; ++m)
#pragma unroll
                    for (int n = 0; n < 2; ++n) acc[a][b][m][n] = (f32x4){0.f, 0.f, 0.f, 0.f};
    } else {
#pragma unroll
        for (int a = 0; a < 2; ++a)
#pragma unroll
            for (int b = 0; b < 2; ++b)
#pragma unroll
                for (int m = 0; m < 4; ++m)
#pragma unroll
                    for (int n = 0; n < 2; ++n) acc[a][b][m][n] = (f32x4){0.f, 0.f, 0.f, 0.f};
    }
}
template <int MODE>
__device__ __forceinline__ void gemm_phase(LAS unsigned char* lds, const Params& p, const int G, const int c) {
    constexpr int K = 1024, nt = (MODE == 0 ? 16 : 20);
    constexpr int nM = NTOK / 256, nN = (MODE == 0 ? 12 : 4);
    const char* Aop = (const char*)(p.ws + (MODE == 0 ? WS_XB : WS_MIX));
    const char* idm = (const char*)(p.ws + WS_ID) - 16 * (size_t)(BK * 2);
    const char* Bop = (const char*)(p.ws + (MODE == 0 ? WS_WIN : WS_WOUT));
    const int tid = threadIdx.x, wid = __builtin_amdgcn_readfirstlane(tid >> 6), lane = tid & 63, wr = wid >> 2, wc = wid & 3, fr = lane & 15, fq = lane >> 4;
    unsigned voffA[2], voffB[2];
#pragma unroll
    for (int i = 0; i < 2; ++i) { int R, C; stage_rc(tid * 16 + i * 8192, R, C); const int Rb = (MODE == 0) ? (64 * (R >> 5) + perm32(R & 31)) : R;
        voffA[i] = (unsigned)(R * K + C) * 2u; voffB[i] = (unsigned)(Rb * K + C) * 2u; }
    constexpr size_t kstep = (size_t)(BK * 2);
    constexpr size_t hstepA = (size_t)HALF * K * 2;
    constexpr size_t hstepB = (size_t)(MODE == 0 ? 32 : 128) * K * 2;
    constexpr size_t tstep = (size_t)256 * K * 2;
    const unsigned ldsw = (unsigned)wid * 1024u;
    const int aoff = lds_byte(wr * 64 + fr, fq * 8), boff = lds_byte(wc * 32 + fr, fq * 8);
#define PG8_SA(b, h) (((b) * 2 + (h)) * HTB)
#define PG8_SB(b, h) ((4 + (b) * 2 + (h)) * HTB)
#define PG8_STAGE(bufoff, gbase, voff) do { _Pragma("unroll") for (int _i = 0; _i < 2; ++_i) \
        __builtin_amdgcn_global_load_lds((const unsigned*)((const char*)(gbase) + (voff)[_i]), (LAS unsigned*)(lds + (bufoff) + ldsw + _i * 8192), 16, 0, 0); } while (0)
#define PG8_LDA(dst, b, h) do { _Pragma("unroll") for (int m = 0; m < 4; ++m) _Pragma("unroll") for (int k = 0; k < 2; ++k) dst[m][k] = *(const LAS bf16x8*)(lds + PG8_SA(b, h) + aoff + m * 2048 + k * 1024); } while (0)
#define PG8_LDB(dst, b, h) do { _Pragma("unroll") for (int n = 0; n < 2; ++n) _Pragma("unroll") for (int k = 0; k < 2; ++k) dst[n][k] = *(const LAS bf16x8*)(lds + PG8_SB(b, h) + boff + n * 2048 + k * 1024); } while (0)
#define PG8_MMA(ai, bj, At, Bt) do { __builtin_amdgcn_s_setprio(1); _Pragma("unroll") for (int m = 0; m < 4; ++m) _Pragma("unroll") for (int n = 0; n < 2; ++n) _Pragma("unroll") for (int k = 0; k < 2; ++k) \
        acc[ai][bj][m][n] = __builtin_amdgcn_mfma_f32_16x16x32_bf16(Bt[n][k], At[m][k], acc[ai][bj][m][n], 0, 0, 0); __builtin_amdgcn_s_setprio(0); } while (0)
#define PG8_WAIT_V(n) asm volatile("s_waitcnt vmcnt(" #n ")" ::: "memory")
#define PG8_WAIT_L(n) asm volatile("s_waitcnt lgkmcnt(" #n ")" ::: "memory")
#define PG8_BAR __builtin_amdgcn_s_barrier()
#define PG8_SCHED __builtin_amdgcn_sched_barrier(0)
#define UNIT_PTRS(u, pa, pb) do { if (MODE == 0 && ((u).pn == 8 || (u).pn == 9)) { pa = Bop + (size_t)(u).pn * tstep; pb = Aop + (size_t)(u).pm * tstep; } \
        else { pa = Aop + (size_t)(u).pm * tstep; pb = Bop + (size_t)(u).pn * tstep; } } while (0)
    Unit cur, nxt; int ui = 0;
    if (!unit_next<nM, nN>(0, G, c, cur)) return;
    f32x4 acc[2][2][4][2];
    acc_init<MODE>(acc, cur, wr, wc, fr, fq, p);
    bf16x8 At[4][2], B0[2][2], B1[2][2];
    const char* cA; const char* cB; UNIT_PTRS(cur, cA, cB);
#define UNIT_X(u) ((const char*)(p.ws + WS_XB) + (size_t)(u).pm * tstep + (size_t)(u).pn * 512 - 16 * kstep)
    const char* cX = UNIT_X(cur);
    PG8_STAGE(PG8_SB(0, 0), cB, voffB); PG8_STAGE(PG8_SA(0, 0), cA, voffA); PG8_STAGE(PG8_SB(0, 1), cB + hstepB, voffB); PG8_STAGE(PG8_SA(0, 1), cA + hstepA, voffA);
    if (wr == 1) PG8_BAR;
    PG8_WAIT_V(4); PG8_BAR;
    PG8_STAGE(PG8_SB(1, 0), cB + kstep, voffB); PG8_STAGE(PG8_SA(1, 0), cA + kstep, voffA); PG8_STAGE(PG8_SB(1, 1), cB + hstepB + kstep, voffB);
    PG8_WAIT_V(6); PG8_BAR;
    for (;;) {
        const bool has_next = unit_next<nM, nN>(ui + 1, G, c, nxt);
        const char* nA = cA; const char* nB = cB; if (has_next) UNIT_PTRS(nxt, nA, nB);
        const char* nX = has_next ? UNIT_X(nxt) : cX;
        for (int t = 0; t < nt; t += 2) {
            const bool last = (t == nt - 2);
            const bool xs1 = (MODE == 1) && (t >= 16), xs2 = (MODE == 1) && (t + 2 >= 16);
            const char* a1 = (xs1 ? cX : cA) + (size_t)(t + 1) * kstep;
            const char* a2 = last ? nA : (xs2 ? cX : cA) + (size_t)(t + 2) * kstep; const char* b2 = last ? nB : (xs2 ? idm : cB) + (size_t)(t + 2) * kstep;
            const char* a3 = a2 + kstep; const char* b3 = b2 + kstep;
            PG8_LDB(B0, 0, 0); PG8_SCHED; PG8_LDA(At, 0, 0); PG8_STAGE(PG8_SA(1, 1), a1 + hstepA, voffA);
            PG8_WAIT_L(8); PG8_BAR; PG8_WAIT_L(0); PG8_MMA(0, 0, At, B0); PG8_BAR; PG8_SCHED;
            PG8_LDB(B1, 0, 1); PG8_STAGE(PG8_SB(0, 0), b2, voffB);
            PG8_BAR; PG8_WAIT_L(0); PG8_MMA(0, 1, At, B1); PG8_BAR;
            PG8_LDA(At, 0, 1); PG8_STAGE(PG8_SA(0, 0), a2, voffA);
            PG8_BAR; PG8_WAIT_L(0); PG8_MMA(1, 0, At, B0); PG8_BAR; PG8_SCHED;
            PG8_STAGE(PG8_SB(0, 1), b2 + hstepB, voffB);
            PG8_WAIT_V(6); PG8_BAR; PG8_MMA(1, 1, At, B1); PG8_BAR;
            PG8_LDB(B0, 1, 0); PG8_SCHED; PG8_LDA(At, 1, 0); PG8_STAGE(PG8_SA(0, 1), a2 + hstepA, voffA);
            PG8_WAIT_L(8); PG8_BAR; PG8_WAIT_L(0); PG8_MMA(0, 0, At, B0); PG8_BAR; PG8_SCHED;
            PG8_LDB(B1, 1, 1); PG8_STAGE(PG8_SB(1, 0), b3, voffB);
            PG8_BAR; PG8_WAIT_L(0); PG8_MMA(0, 1, At, B1); PG8_BAR;
            PG8_LDA(At, 1, 1); PG8_STAGE(PG8_SA(1, 0), a3, voffA);
            PG8_BAR; PG8_WAIT_L(0); PG8_MMA(1, 0, At, B0); PG8_BAR; PG8_SCHED;
            PG8_STAGE(PG8_SB(1, 1), b3 + hstepB, voffB);
            PG8_WAIT_V(6); PG8_BAR; PG8_MMA(1, 1, At, B1); PG8_BAR;
        }
        if (MODE == 0) epi_gemm1(acc, cur, wr, wc, fr, fq, p); else epi_gemm2(acc, cur, wr, wc, fr, fq, p);
        if (!has_next) break;
        acc_init<MODE>(acc, nxt, wr, wc, fr, fq, p);
        cur = nxt; cA = nA; cB = nB; cX = nX; ++ui;
    }
    PG8_WAIT_V(0);
    if (wr == 0) PG8_BAR;
    PG8_BAR;
#undef PG8_SA
#undef PG8_SB
#undef PG8_STAGE
#undef PG8_LDA
#undef PG8_LDB
#undef PG8_MMA
#undef UNIT_PTRS
#undef UNIT_X
}

constexpr int PSTR = 1040;
constexpr int RPB_OFF = 147456;
#define SCHED_FENCE __builtin_amdgcn_sched_barrier(0)
__device__ __forceinline__ void acc8(float (&a)[8], u32x4 w, const float sgn) { asm("" : "+v"(w));
    a[0] += sgn * bf_lo(w.x); a[1] += sgn * bf_hi(w.x); a[2] += sgn * bf_lo(w.y); a[3] += sgn * bf_hi(w.y);
    a[4] += sgn * bf_lo(w.z); a[5] += sgn * bf_hi(w.z); a[6] += sgn * bf_lo(w.w); a[7] += sgn * bf_hi(w.w);
}
template <int A> __device__ __forceinline__ void pool_a(LAS unsigned char* ldsdst, const bf16_t* Ub, const int pos0, const int S) {
    constexpr int NR = 8 + 2 * A - 1;
    u32x4 rows[NR];
#pragma unroll
    for (int j = 0; j < NR; ++j) { const int pos = pos0 - A + j; const int pc = pos < 0 ? 0 : (pos >= S ? S - 1 : pos); rows[j] = *(const u32x4*)(Ub + (size_t)pc * 512); }
    SCHED_FENCE;
#pragma unroll
    for (int j = 0; j < NR; ++j) { const int pos = pos0 - A + j; if (pos < 0 || pos >= S) rows[j] = (u32x4){0u, 0u, 0u, 0u}; }
    float acc[8];
#pragma unroll
    for (int j = 0; j < 8; ++j) acc[j] = 0.f;
#pragma unroll
    for (int j = 0; j < 2 * A; ++j) acc8(acc, rows[j], 1.0f);
#pragma unroll
    for (int t = 0; t < 8; ++t) {
        const int pos = pos0 + t; const int hi = (pos + A < S) ? pos + A : S, lo = (pos - A > 0) ? pos - A : 0;
        const float inv = 1.0f / (float)(hi - lo);
        const u32x4 cw = rows[A + t];
        float o[8];
        o[0] = acc[0] * inv - bf_lo(cw.x); o[1] = acc[1] * inv - bf_hi(cw.x); o[2] = acc[2] * inv - bf_lo(cw.y); o[3] = acc[3] * inv - bf_hi(cw.y);
        o[4] = acc[4] * inv - bf_lo(cw.z); o[5] = acc[5] * inv - bf_hi(cw.z); o[6] = acc[6] * inv - bf_lo(cw.w); o[7] = acc[7] * inv - bf_hi(cw.w);
        u32x4 w; w.x = cvt_pk_bf16(o[0], o[1]); w.y = cvt_pk_bf16(o[2], o[3]); w.z = cvt_pk_bf16(o[4], o[5]); w.w = cvt_pk_bf16(o[6], o[7]);
        *(LAS u32x4*)(ldsdst + t * PSTR) = w;
        if (t < 7) { acc8(acc, rows[2 * A + t], 1.0f); acc8(acc, rows[t], -1.0f); }
    }
}
__device__ __forceinline__ void mixer_phase(LAS unsigned char* lds, const Params& p, const int G, const int c) {
    const int tid = threadIdx.x, lane = tid & 63, wid = __builtin_amdgcn_readfirstlane(tid >> 6), fr = lane & 15, fq = lane >> 4;
    const bf16_t* aU = (const bf16_t*)(p.ws + WS_ACT); const bf16_t* aGP = aU + ACT_STRIDE; const bf16_t* aQ = aU + 2 * ACT_STRIDE; const bf16_t* aK = aU + 3 * ACT_STRIDE; const bf16_t* aGA = aU + 4 * ACT_STRIDE;
    const bf16_t* VT = (const bf16_t*)(p.ws + WS_VT); const bf16_t* WpT = (const bf16_t*)(p.ws + WS_WP);
    bf16_t* MIX = (bf16_t*)(p.ws + WS_MIX); const float* rsb = (const float*)(p.ws + WS_RS);
    LAS float* rpbs = (LAS float*)(lds + RPB_OFF);
    for (int i = tid; i < 8 * 465; i += 512) rpbs[i] = p.rpb[i];
    __syncthreads();
    bf16x8 bfr[4][4]; f32x4 psv[4];
    {
        const int g = wid >> 1, dh = wid & 1;
        const bf16_t* wb = WpT + (size_t)(g * 128 + 64 * dh + fr) * 128 + 8 * fq;
#pragma unroll
        for (int nt = 0; nt < 4; ++nt)
#pragma unroll
            for (int ks = 0; ks < 4; ++ks) bfr[nt][ks] = *(const bf16x8*)(wb + nt * 16 * 128 + 32 * ks);
#pragma unroll
        for (int nt = 0; nt < 4; ++nt) psv[nt] = *(const f32x4*)(p.pool_scale + 128 * g + 64 * dh + 16 * nt + 4 * fq);
    }
    for (int it = 0;; ++it) {
        const int L = it * G + c; if (L >= 1280) break;
        const int gr = (L & 7) * 160 + (L >> 3);
        int R, r; if (gr < 1024) { R = 64; r = gr & 63; } else { R = 128; r = (gr - 1024) & 127; }
        const int gr0 = gr - r; const int S = R * 64;
        {
            const int g = wid >> 1, th = wid & 1;
            const int c0 = 128 * g + 8 * fr, tl0 = 32 * th + 8 * fq, pos0 = r * 64 + tl0;
            const bf16_t* Ub = aU + (size_t)gr0 * 64 * 512 + c0;
            LAS unsigned char* dst = lds + (it & 1) * (64 * PSTR) + tl0 * PSTR + c0 * 2;
            if (g == 0) pool_a<1>(dst, Ub, pos0, S); else if (g == 1) pool_a<2>(dst, Ub, pos0, S); else if (g == 2) pool_a<4>(dst, Ub, pos0, S); else pool_a<8>(dst, Ub, pos0, S);
        }
        {
            const int g = wid >> 1, dh = wid & 1;
            u32x2 gw[4][4];
            const bf16_t* gb = aGP + ((size_t)gr * 64 + fr) * 512 + 128 * g + 64 * dh + 4 * fq;
#pragma unroll
            for (int mt = 0; mt < 4; ++mt)
#pragma unroll
                for (int nt = 0; nt < 4; ++nt) gw[mt][nt] = *(const u32x2*)(gb + (size_t)mt * 16 * 512 + 16 * nt);
            float rsm[4];
#pragma unroll
            for (int mt = 0; mt < 4; ++mt) rsm[mt] = rsb[(size_t)gr * 64 + 16 * mt + fr];
            SCHED_FENCE;
            __syncthreads();
            f32x4 acc[4][4];
#pragma unroll
            for (int mt = 0; mt < 4; ++mt)
#pragma unroll
                for (int nt = 0; nt < 4; ++nt) acc[mt][nt] = (f32x4){0.f, 0.f, 0.f, 0.f};
#pragma unroll
            for (int ks = 0; ks < 4; ++ks) {
                bf16x8 af[4];
#pragma unroll
                for (int mt = 0; mt < 4; ++mt) af[mt] = *(const LAS bf16x8*)(lds + (it & 1) * (64 * PSTR) + (16 * mt + fr) * PSTR + (128 * g + 32 * ks + 8 * fq) * 2);
#pragma unroll
                for (int mt = 0; mt < 4; ++mt)
#pragma unroll
                    for (int nt = 0; nt < 4; ++nt) acc[mt][nt] = __builtin_amdgcn_mfma_f32_16x16x32_bf16(bfr[nt][ks], af[mt], acc[mt][nt], 0, 0, 0);
            }
            bf16_t* mb = MIX + ((size_t)gr * 64 + fr) * 1024 + 128 * g + 64 * dh + 4 * fq;
#pragma unroll
            for (int mt = 0; mt < 4; ++mt)
#pragma unroll
                for (int nt = 0; nt < 4; ++nt) {
                    const f32x4 a4 = acc[mt][nt] * rsm[mt]; const u32x2 gg = gw[mt][nt];
                    u32x2 w; w.x = cvt_pk_bf16(a4[0] * psv[nt][0] * bf_lo(gg.x), a4[1] * psv[nt][1] * bf_hi(gg.x)); w.y = cvt_pk_bf16(a4[2] * psv[nt][2] * bf_lo(gg.y), a4[3] * psv[nt][3] * bf_hi(gg.y));
                    *(u32x2*)(mb + (size_t)mt * 16 * 1024 + 16 * nt) = w;
                }
        }
    }
    __syncthreads();
}
constexpr int VREG = 73728;
#define A_BAR() do { SCHED_FENCE; asm volatile("s_waitcnt lgkmcnt(0)" ::: "memory"); __builtin_amdgcn_s_barrier(); SCHED_FENCE; } while (0)
__device__ __forceinline__ void gload16_asm(bf16x8& v, const void* ptr) { asm volatile("global_load_dwordx4 %0, %1, off" : "=v"(v) : "v"(ptr) : "memory"); }
__device__ __forceinline__ void gload4_asm(float& v, const void* ptr) { asm volatile("global_load_dword %0, %1, off" : "=v"(v) : "v"(ptr) : "memory"); }
__device__ __forceinline__ void gload8_asm(u32x2& v, const void* ptr) { asm volatile("global_load_dwordx2 %0, %1, off" : "=v"(v) : "v"(ptr) : "memory"); }
struct AUnit { int gr0, R, r0, h, gA, win; };
__device__ __forceinline__ int win_start(int r, int R) { int s = r - 4; s = s < 0 ? 0 : s; return s > R - 8 ? R - 8 : s; }
__device__ __forceinline__ void attn_decode(int L, int G, AUnit& u) {
    int pp;
    if (G == 256) { const int it = L >> 8, c = L & 255, xcd = c & 7, j = c >> 3; u.h = j & 7; pp = 80 * xcd + 20 * (j >> 3) + it; }
    else { const int xcd = L & 7, q = L >> 3; pp = 80 * xcd + (q >> 3); u.h = q & 7; }
    u.gA = 2 * pp;
    if (u.gA < 1024) { u.R = 64; u.r0 = u.gA & 63; } else { u.R = 128; u.r0 = (u.gA - 1024) & 127; }
    u.gr0 = u.gA - u.r0; u.win = win_start(u.r0, u.R);
}
__device__ __forceinline__ void stage_K(LAS unsigned char* lds, const bf16_t* aK, const AUnit& u, int wid, int lane, int pa) {
    const int rsU = u.win; const int col = 8 * wid + (lane >> 3); const int ch = (lane & 7) ^ ((col >> 1) & 7);
    const bf16_t* src = aK + (size_t)col * 512 + u.h * 64 + ch * 8;
#pragma unroll
    for (int m = 0; m < 9; ++m) { int rw = rsU + m; rw = rw > u.R - 1 ? u.R - 1 : rw;
        if (rw < pa || rw > pa + 8) __builtin_amdgcn_global_load_lds((const unsigned*)(src + (size_t)(u.gr0 + rw) * 64 * 512), (LAS unsigned*)(lds + (wid + 8 * (rw % 9)) * 1024), 16, 0, 0); }
}
__device__ __forceinline__ void stage_V(LAS unsigned char* lds, const bf16_t* VT, const AUnit& u, int wid, int lane, int pa) {
    const int rsU = u.win; const int d = 8 * wid + (lane >> 3); const int ch = (lane & 7) ^ ((d >> 1) & 7);
    const bf16_t* src = VT + (size_t)u.h * 4096 + d * 64 + ch * 8;
#pragma unroll
    for (int m = 0; m < 9; ++m) { int rw = rsU + m; rw = rw > u.R - 1 ? u.R - 1 : rw;
        if (rw < pa || rw > pa + 8) __builtin_amdgcn_global_load_lds((const unsigned*)(src + (size_t)(u.gr0 + rw) * 8 * 4096), (LAS unsigned*)(lds + VREG + (wid + 8 * (rw % 9)) * 1024), 16, 0, 0); }
}
__device__ __forceinline__ void attn_phase(LAS unsigned char* lds, const Params& p, const int G, const int c) {
    const int tid = threadIdx.x, lane = tid & 63, wid = __builtin_amdgcn_readfirstlane(tid >> 6), fr = lane & 15, fq = lane >> 4;
    const bf16_t* aU = (const bf16_t*)(p.ws + WS_ACT); const bf16_t* aQ = aU + 2 * ACT_STRIDE; const bf16_t* aK = aU + 3 * ACT_STRIDE; const bf16_t* aGA = aU + 4 * ACT_STRIDE;
    const bf16_t* VT = (const bf16_t*)(p.ws + WS_VT);
    bf16_t* MIX = (bf16_t*)(p.ws + WS_MIX); const float* rsb = (const float*)(p.ws + WS_RS);
    const LAS float* rpbs = (const LAS float*)(lds + RPB_OFF);
    const int sel = wid >> 2, qb = wid & 3;
    const int ws_ = (qb == 0) ? 0 : (qb == 1) ? 8 : (qb == 2) ? 24 : 32;
    int kofs[2][2], vofs[4];
#pragma unroll
    for (int t = 0; t < 2; ++t) { const int kc = ws_ + 8 * (fr >> 2) + 4 * t + (fr & 3); const int sw = (kc >> 1) & 7; kofs[t][0] = kc * 128 + ((fq ^ sw) << 4); kofs[t][1] = kc * 128 + (((fq | 4) ^ sw) << 4); }
#pragma unroll
    for (int dt = 0; dt < 4; ++dt) { const int d = 16 * dt + fr; vofs[dt] = VREG + d * 128 + ((((ws_ >> 3) + fq) ^ ((d >> 1) & 7)) << 4); }
    const int cq = 16 * qb + fr; int cs = cq - 8; cs = cs < 0 ? 0 : cs; cs = cs > 48 ? 48 : cs;
    int L = c; if (L >= 5120) return;
    if (wid >= 4) __builtin_amdgcn_s_setprio(1);
    AUnit cur, nxt; attn_decode(L, G, cur);
    stage_K(lds, aK, cur, wid, lane, -100);
    int pgr0 = -1, pwin = 0;
    size_t qtok = (size_t)(cur.gA + sel) * 64 + 16 * qb + fr;
    bf16x8 qf0, qf1; u32x2 gw[4];
    SCHED_FENCE;
    gload16_asm(qf0, aQ + qtok * 512 + cur.h * 64 + 8 * fq); gload16_asm(qf1, aQ + qtok * 512 + cur.h * 64 + 32 + 8 * fq);
#pragma unroll
    for (int dt = 0; dt < 4; ++dt) gload8_asm(gw[dt], aGA + qtok * 512 + cur.h * 64 + 16 * dt + 4 * fq);
    float rsq; gload4_asm(rsq, rsb + qtok);
    SCHED_FENCE;
    SCHED_FENCE; asm volatile("s_waitcnt vmcnt(0)" ::: "memory"); SCHED_FENCE;
    for (;;) {
        const int r = cur.r0 + sel; const int rs0 = win_start(r, cur.R); const int sb = rs0 % 9;
        const LAS float* rb = rpbs + cur.h * 465 + (rs0 - r + 7) * 31;
        const int h = cur.h;
        SCHED_FENCE; asm volatile("s_waitcnt vmcnt(4) lgkmcnt(0)" ::: "memory"); __builtin_amdgcn_s_barrier(); SCHED_FENCE;
        asm volatile("" : "+v"(qf0), "+v"(qf1)); SCHED_FENCE;
        stage_V(lds, VT, cur, wid, lane, (pgr0 == cur.gr0) ? pwin : -100);
        pgr0 = cur.gr0; pwin = cur.win;
        SCHED_FENCE;
        const int Ln = L + G; const bool has_next = Ln < 5120;
        nxt = cur; if (has_next) attn_decode(Ln, G, nxt);
        const size_t qtok_n = (size_t)(nxt.gA + sel) * 64 + 16 * qb + fr;
        bf16x8 qn0, qn1; u32x2 gn[4];
        gload16_asm(qn0, aQ + qtok_n * 512 + nxt.h * 64 + 8 * fq); gload16_asm(qn1, aQ + qtok_n * 512 + nxt.h * 64 + 32 + 8 * fq);
#pragma unroll
        for (int dt = 0; dt < 4; ++dt) gload8_asm(gn[dt], aGA + qtok_n * 512 + nxt.h * 64 + 16 * dt + 4 * fq);
        float rsn; gload4_asm(rsn, rsb + qtok_n);
        SCHED_FENCE;
        f32x4 s[8][2];
        {
            const LAS unsigned char* kb = lds;
#pragma unroll
            for (int i = 0; i < 8; ++i)
#pragma unroll
                for (int t = 0; t < 2; ++t) {
                    const int so = ((sb + i >= 9) ? sb + i - 9 : sb + i) * 8192;
                    const bf16x8 k0 = *(const LAS bf16x8*)(kb + kofs[t][0] + so), k1 = *(const LAS bf16x8*)(kb + kofs[t][1] + so);
                    f32x4 z = (f32x4){0.f, 0.f, 0.f, 0.f};
                    z = __builtin_amdgcn_mfma_f32_16x16x32_bf16(k0, qf0, z, 0, 0, 0);
                    z = __builtin_amdgcn_mfma_f32_16x16x32_bf16(k1, qf1, z, 0, 0, 0);
                    s[i][t] = z;
                }
        }
        typedef float f32x2 __attribute__((ext_vector_type(2)));
        f32x2 sv[8][2][2];
        float mx = -1e30f;
#pragma unroll
        for (int t = 0; t < 2; ++t)
#pragma unroll
            for (int jp = 0; jp < 2; ++jp) {
                f32x2 mk1, mk2; int bi2[2];
#pragma unroll
                for (int e = 0; e < 2; ++e) { const int j = 2 * jp + e; const int kc = ws_ + 8 * fq + 4 * t + j; const bool valid = (kc >= cs) && (kc < cs + 16);
                    int bi = kc - cq + 15; bi = bi < 0 ? 0 : bi; bi = bi > 30 ? 30 : bi; bi2[e] = bi; mk1[e] = valid ? 1.0f : 0.0f; mk2[e] = valid ? 0.0f : -1e30f; }
#pragma unroll
                for (int i = 0; i < 8; ++i) { f32x2 bb; bb.x = rb[i * 31 + bi2[0]]; bb.y = rb[i * 31 + bi2[1]];
                    f32x2 x; x.x = s[i][t][2 * jp]; x.y = s[i][t][2 * jp + 1];
                    const f32x2 v = (x + bb) * mk1 + mk2; sv[i][t][jp] = v; mx = fmaxf(mx, fmaxf(v.x, v.y)); }
            }
        mx = xmax4(mx);
        const float mxl = mx * 1.44269504f;
        const f32x2 c2 = (f32x2){1.44269504f, 1.44269504f}, m2 = (f32x2){-mxl, -mxl};
        f32x2 sum2 = (f32x2){0.f, 0.f};
#pragma unroll
        for (int i = 0; i < 8; ++i)
#pragma unroll
            for (int t = 0; t < 2; ++t)
#pragma unroll
                for (int jp = 0; jp < 2; ++jp) { const f32x2 a2 = sv[i][t][jp] * c2 + m2; f32x2 e; e.x = __builtin_amdgcn_exp2f(a2.x); e.y = __builtin_amdgcn_exp2f(a2.y);
                    s[i][t][2 * jp] = e.x; s[i][t][2 * jp + 1] = e.y; sum2 += e; }
        float sum = sum2.x + sum2.y;
        sum = xsum4(sum);
        const float inv0 = 1.0f / sum;
        bf16x8 pf[8];
#pragma unroll
        for (int i = 0; i < 8; ++i) {
            u32x4 pw; pw.x = cvt_pk_bf16(s[i][0][0], s[i][0][1]); pw.y = cvt_pk_bf16(s[i][0][2], s[i][0][3]);
            pw.z = cvt_pk_bf16(s[i][1][0], s[i][1][1]); pw.w = cvt_pk_bf16(s[i][1][2], s[i][1][3]);
            pf[i] = __builtin_bit_cast(bf16x8, pw);
        }
        SCHED_FENCE; asm volatile("s_waitcnt vmcnt(0) lgkmcnt(0)" ::: "memory"); __builtin_amdgcn_s_barrier(); SCHED_FENCE;
        stage_K(lds, aK, nxt, wid, lane, (nxt.gr0 == cur.gr0) ? cur.win : -100);
        SCHED_FENCE;
        asm volatile("" : "+v"(qn0), "+v"(qn1), "+v"(gn[0]), "+v"(gn[1]), "+v"(gn[2]), "+v"(gn[3]), "+v"(gw[0]), "+v"(gw[1]), "+v"(gw[2]), "+v"(gw[3]), "+v"(rsn), "+v"(rsq)); SCHED_FENCE;
        f32x4 o[4];
#pragma unroll
        for (int dt = 0; dt < 4; ++dt) o[dt] = (f32x4){0.f, 0.f, 0.f, 0.f};
        {
            const LAS unsigned char* vb = lds;
#pragma unroll
            for (int i = 0; i < 8; ++i)
#pragma unroll
                for (int dt = 0; dt < 4; ++dt) { const int so = ((sb + i >= 9) ? sb + i - 9 : sb + i) * 8192;
                    const bf16x8 vf = *(const LAS bf16x8*)(vb + vofs[dt] + so); o[dt] = __builtin_amdgcn_mfma_f32_16x16x32_bf16(vf, pf[i], o[dt], 0, 0, 0); }
        }
#pragma unroll
        for (int dt = 0; dt < 4; ++dt) {
            const int chn = h * 64 + 16 * dt + 4 * fq;
            const float inv = inv0 * rsq;
            u32x2 w; w.x = cvt_pk_bf16(o[dt][0] * inv * bf_lo(gw[dt].x), o[dt][1] * inv * bf_hi(gw[dt].x)); w.y = cvt_pk_bf16(o[dt][2] * inv * bf_lo(gw[dt].y), o[dt][3] * inv * bf_hi(gw[dt].y));
            *(u32x2*)(MIX + qtok * 1024 + 512 + chn) = w;
        }
        if (!has_next) break;
        cur = nxt; L = Ln; qtok = qtok_n; qf0 = qn0; qf1 = qn1; rsq = rsn;
#pragma unroll
        for (int dt = 0; dt < 4; ++dt) gw[dt] = gn[dt];
    }
    asm volatile("s_waitcnt vmcnt(0)" ::: "memory"); __builtin_amdgcn_s_barrier();
    __builtin_amdgcn_s_setprio(0);
}


}
__global__ void __launch_bounds__(512, 2) fwd_kernel(Params p) {
    extern __shared__ __attribute__((aligned(16))) unsigned char shm[];
    LAS unsigned char* lds = (LAS unsigned char*)shm;
    const int G = gridDim.x, c = blockIdx.x;
    cg::grid_group grid = cg::this_grid();
#ifndef REP0
#define REP0 1
#endif
#ifndef REP1
#define REP1 1
#endif
#ifndef REP2
#define REP2 1
#endif
#ifndef REP3
#define REP3 1
#endif
    volatile LAS unsigned* bst = (volatile LAS unsigned*)(lds + 147456 + 8 * 465 * 4);
    if (threadIdx.x < 2) bst[threadIdx.x] = 0u;
    __syncthreads();
    XcdBarrier xbar = xcd_barrier_post((unsigned*)(p.ws + WS_BAR), bst);
#define GRID_SYNC() do { if (p.coop) { if (p.use_cg) grid.sync(); else xcd_barrier(xbar); } } while (0)
    if (p.ph_lo <= 0 && 0 < p.ph_hi) { for (int rep = 0; rep < REP0; ++rep) { prep_phase(p, G); GRID_SYNC(); } }
    if (p.ph_lo <= 1 && 1 < p.ph_hi) { for (int rep = 0; rep < REP1; ++rep) { gemm_phase<0>(lds, p, G, c); GRID_SYNC(); } }
    if (p.ph_lo <= 2 && 2 < p.ph_hi) { for (int rep = 0; rep < REP2; ++rep) { mixer_phase(lds, p, G, c); attn_phase(lds, p, G, c); GRID_SYNC(); } }
    if (p.ph_lo <= 3 && 3 < p.ph_hi) { for (int rep = 0; rep < REP3; ++rep) { gemm_phase<1>(lds, p, G, c); if (REP3 > 1 && p.coop) grid.sync(); } }
}

#ifndef N_LAUNCHES
#define N_LAUNCHES 1
#endif

extern "C" void kernel_launch(void* const* d_in, const int* in_sizes, int n_in, void* d_out, int out_size, void* d_ws, size_t ws_size, hipStream_t stream) {
    static int grid = 0;
    if (grid == 0) {
        if (n_in != 10 || ws_size < WS_END) { fprintf(stderr, "kernel_launch: unexpected inputs (n_in %d, ws %zu < %zu)\n", n_in, ws_size, (size_t)WS_END); grid = -1; return; }
        int dev = 0, cus = 0, per_cu = 0;
        (void)hipGetDevice(&dev); (void)hipDeviceGetAttribute(&cus, hipDeviceAttributeMultiprocessorCount, dev);
        if (hipFuncSetAttribute((const void*)fwd_kernel, hipFuncAttributeMaxDynamicSharedMemorySize, LDS_BYTES) != hipSuccess) { fprintf(stderr, "kernel_launch: hipFuncSetAttribute failed\n"); grid = -1; return; }
        (void)hipOccupancyMaxActiveBlocksPerMultiprocessor(&per_cu, (const void*)fwd_kernel, 512, LDS_BYTES);
        (void)hipGetLastError();
        if (per_cu < 1) per_cu = 1;
        grid = cus;
    }
    if (grid < 0) return;
    Params p{};
    p.xp = (const float*)d_in[0]; p.xs = (const float*)d_in[1]; p.norm_g = (const float*)d_in[2]; p.w_in = (const float*)d_in[3]; p.w_pool = (const float*)d_in[4];
    p.pool_scale = (const float*)d_in[5]; p.qg = (const float*)d_in[6]; p.kg = (const float*)d_in[7]; p.rpb = (const float*)d_in[8]; p.w_out = (const float*)d_in[9];
    p.out = (float*)d_out; p.ws = (unsigned char*)d_ws; p.use_cg = 0;
    (void)hipMemsetAsync((char*)d_ws + WS_BAR, 0, XCD_BAR_WORDS * 4, stream);
#if N_LAUNCHES == 1
    p.ph_lo = 0; p.ph_hi = 4; p.coop = 1;
    void* args[] = {&p};
    hipError_t e = hipLaunchCooperativeKernel((const void*)fwd_kernel, dim3(grid), dim3(512), args, LDS_BYTES, stream);
    if (e != hipSuccess) fprintf(stderr, "cooperative launch failed: %s (grid %d)\n", hipGetErrorString(e), grid);
#else
    for (int ph = 0; ph < 4; ++ph) { p.ph_lo = ph; p.ph_hi = ph + 1; p.coop = 0; hipLaunchKernelGGL(fwd_kernel, dim3(grid), dim3(512), LDS_BYTES, stream, p); }
#endif
}
```

```cpp
#include <hip/hip_runtime.h>
#include <hip/hip_cooperative_groups.h>
#include <cstdio>
namespace cg = cooperative_groups;

#define LAS __attribute__((address_space(3)))
typedef unsigned short bf16_t;
typedef short bf16x8 __attribute__((ext_vector_type(8)));
typedef float f32x4 __attribute__((ext_vector_type(4)));
typedef unsigned u32x4 __attribute__((ext_vector_type(4)));
typedef unsigned u32x2 __attribute__((ext_vector_type(2)));

namespace {
constexpr int NTOK = 81920, NTOK_P = 65536;
constexpr float EPS = 1e-6f;
constexpr int BM = 256, BK = 64, HALF = 128, HTB = HALF * BK * 2, STAGE_BYTES = 8 * HTB;
constexpr int LDS_BYTES = 147456 + 8 * 465 * 4 + 16;
constexpr size_t ACT_STRIDE = (size_t)NTOK * 512;
constexpr size_t WS_XB = 0;
constexpr size_t WS_RS = WS_XB + (size_t)NTOK * 1024 * 2;
constexpr size_t WS_WIN = WS_RS + (size_t)NTOK * 4;
constexpr size_t WS_WOUT = WS_WIN + (size_t)3072 * 1024 * 2;
constexpr size_t WS_WP = WS_WOUT + (size_t)1024 * 1024 * 2;
constexpr size_t WS_ACT = WS_WP + (size_t)4 * 128 * 128 * 2;
constexpr size_t WS_VT = WS_ACT + 5 * ACT_STRIDE * 2;
constexpr size_t WS_MIX = WS_VT + ACT_STRIDE * 2;
constexpr size_t WS_RSI = WS_MIX + (size_t)NTOK * 1024 * 2;
constexpr size_t WS_ID = WS_RSI + (size_t)NTOK * 4;
constexpr size_t WS_BAR = WS_ID + (size_t)256 * 1024 * 2;
constexpr size_t WS_END = WS_BAR + 16384;

struct Params {
    const float* xp; const float* xs; const float* norm_g; const float* w_in; const float* w_pool; const float* pool_scale;
    const float* qg; const float* kg; const float* rpb; const float* w_out; float* out; unsigned char* ws;
    int ph_lo, ph_hi, coop, use_cg;
};
#define XB_TMO      128
#define XB_XCNT(j)  (256  + 64 * (j))
#define XB_XSUB(j)  (1280 + 64 * (j))
#define XB_XGEN(j)  (2304 + 64 * (j))
#define XB_TOP      3328
#define XB_TOPGEN   3392
#define XCD_BAR_WORDS 3456
#define XB_SPIN_CAP (1u << 22)
__device__ __forceinline__ unsigned xb_ld(unsigned* p)              { return __hip_atomic_load(p, __ATOMIC_RELAXED, __HIP_MEMORY_SCOPE_AGENT); }
__device__ __forceinline__ unsigned xb_add(unsigned* p, unsigned v) { return __hip_atomic_fetch_add(p, v, __ATOMIC_RELAXED, __HIP_MEMORY_SCOPE_AGENT); }
__device__ __forceinline__ unsigned xb_xcc_id() { return (unsigned)__builtin_amdgcn_s_getreg((3 << 11) | 20) & 0xFu; }
#define XB_SPIN(cond, bar) do { unsigned _sp = 0; while (cond) { __builtin_amdgcn_s_sleep(1); \
    if ((++_sp & 255u) == 0u) { if (xb_ld(&(bar)[XB_TMO])) break; if (_sp > XB_SPIN_CAP) { atomicAdd(&(bar)[XB_TMO], 1u); break; } } } } while (0)
struct XcdBarrier { unsigned* bar; unsigned x; volatile LAS unsigned* st; };
__device__ __forceinline__ XcdBarrier xcd_barrier_post(unsigned* bar, volatile LAS unsigned* st) {
    XcdBarrier b; b.bar = bar; b.x = xb_xcc_id(); b.st = st;
    if (threadIdx.x == 0) (void)xb_add(&bar[XB_XCNT(b.x)], 1u);
    return b;
}
__device__ __forceinline__ void xcd_barrier_complete(unsigned* bar, unsigned x, unsigned& nloc, unsigned& nx) {
    const unsigned G = gridDim.x * gridDim.y * gridDim.z;
    unsigned sum, cnt, mine, sp = 0u;
    for (;;) {
        sum = 0u; cnt = 0u; mine = 0u;
#pragma unroll
        for (unsigned j = 0; j < 16; ++j) { const unsigned c = xb_ld(&bar[XB_XCNT(j)]); sum += c; cnt += (c > 0u) ? 1u : 0u; mine = (j == x) ? c : mine; }
        if (sum == G) break;
        __builtin_amdgcn_s_sleep(1);
        if ((++sp & 255u) == 0u) { if (xb_ld(&bar[XB_TMO])) break; if (sp > XB_SPIN_CAP) { atomicAdd(&bar[XB_TMO], 1u); break; } }
    }
    nloc = mine > 0u ? mine : 1u; nx = cnt > 0u ? cnt : 1u;
}
__device__ __forceinline__ void xcd_barrier(const XcdBarrier& b) {
    asm volatile("s_waitcnt vmcnt(0) lgkmcnt(0)" ::: "memory");
    __syncthreads();
    if (threadIdx.x == 0) {
        unsigned* bar = b.bar;
        __builtin_amdgcn_s_waitcnt(0);
        unsigned nloc = b.st[0], nx = b.st[1];
        if (nloc == 0u) { xcd_barrier_complete(bar, b.x, nloc, nx); b.st[0] = nloc; b.st[1] = nx; }
        const unsigned old = xb_add(&bar[XB_XSUB(b.x)], 1u);
        const unsigned gen = old / nloc;
        if (old + 1u == (gen + 1u) * nloc) {
            __builtin_amdgcn_fence(__ATOMIC_RELEASE, "agent");
            asm volatile("s_waitcnt vmcnt(0)" ::: "memory");
            const unsigned og = xb_add(&bar[XB_TOP], 1u);
            const unsigned tg = og / nx;
            if (og + 1u == (tg + 1u) * nx) xb_add(&bar[XB_TOPGEN], 1u);
            else XB_SPIN(xb_ld(&bar[XB_TOPGEN]) == tg, bar);
            __builtin_amdgcn_fence(__ATOMIC_ACQUIRE, "agent");
            xb_add(&bar[XB_XGEN(b.x)], 1u);
            asm volatile("s_waitcnt vmcnt(0)" ::: "memory");
        } else {
            XB_SPIN(xb_ld(&bar[XB_XGEN(b.x)]) == gen, bar);
            __builtin_amdgcn_fence(__ATOMIC_ACQUIRE, "agent");
            asm volatile("s_waitcnt vmcnt(0)" ::: "memory");
        }
    }
    __syncthreads();
}

__device__ __forceinline__ unsigned cvt_pk_bf16(float lo, float hi) { unsigned r; asm("v_cvt_pk_bf16_f32 %0, %1, %2" : "=v"(r) : "v"(lo), "v"(hi)); return r; }
__device__ __forceinline__ float bf_lo(unsigned w) { return __uint_as_float(w << 16); }
__device__ __forceinline__ float bf_hi(unsigned w) { return __uint_as_float(w & 0xffff0000u); }
typedef unsigned xr_u2 __attribute__((ext_vector_type(2)));
__device__ __forceinline__ float xsum4(float x) {
    xr_u2 r = __builtin_amdgcn_permlane32_swap(__float_as_uint(x), __float_as_uint(x), false, false); const float s = __uint_as_float(r.x) + __uint_as_float(r.y);
    xr_u2 q = __builtin_amdgcn_permlane16_swap(__float_as_uint(s), __float_as_uint(s), false, false); return __uint_as_float(q.x) + __uint_as_float(q.y);
}
__device__ __forceinline__ float xmax4(float x) {
    xr_u2 r = __builtin_amdgcn_permlane32_swap(__float_as_uint(x), __float_as_uint(x), false, false); const float s = fmaxf(__uint_as_float(r.x), __uint_as_float(r.y));
    xr_u2 q = __builtin_amdgcn_permlane16_swap(__float_as_uint(s), __float_as_uint(s), false, false); return fmaxf(__uint_as_float(q.x), __uint_as_float(q.y));
}
__device__ __forceinline__ float silu_f(float v) { return v * __builtin_amdgcn_rcpf(1.0f + __expf(-v)); }

__device__ __forceinline__ int lds_byte(int r, int c) { const int st = (r >> 4) * 2 + (c >> 5), rr = r & 15, cc = c & 31, ob = rr * 64 + cc * 2; return st * 1024 + (ob ^ (((ob >> 9) & 1) << 5)); }
__device__ __forceinline__ void stage_rc(int b, int& R, int& C) { const int st = b / 1024, sb = b % 1024, swz = sb ^ (((sb >> 9) & 1) << 5); R = (st >> 1) * 16 + swz / 64; C = (st & 1) * 32 + (swz % 64) / 2; }
__device__ __forceinline__ int perm32(int rho) { const int n = rho >> 4, i = rho & 15; return 8 * (i >> 2) + 4 * n + (i & 3); }

struct Unit { int pm, pn; };
template <int nM, int nN> __device__ __forceinline__ bool unit_next(int i, int G, int c, Unit& u) {
    constexpr int nwg = nM * nN; const long L = (long)i * G + c; if (L >= nwg) return false;
    int wgid = (int)L; { constexpr int q = nwg / 8, r = nwg % 8; const int xcd = wgid % 8, off = wgid / 8; wgid = (xcd < r ? xcd * (q + 1) : r * (q + 1) + (xcd - r) * q) + off; }
    constexpr int nig = 8 * nN; const int gid = wgid / nig, fm = gid * 8, gsz = (nM - fm) < 8 ? (nM - fm) : 8;
    u.pm = fm + ((wgid % nig) % gsz); u.pn = (wgid % nig) / gsz; return true;
}

__device__ __forceinline__ void prep_phase(const Params& p, int G) {
    const int tid = threadIdx.x, lane = tid & 63, wid = tid >> 6;
    bf16_t* xb = (bf16_t*)(p.ws + WS_XB); float* rsb = (float*)(p.ws + WS_RS); float* rsib = (float*)(p.ws + WS_RSI);
    const int nw = G * 8;
    const int gt = blockIdx.x * 512 + tid, T = G * 512; const bool fastw = (T == 131072);
    bf16_t* WinT = (bf16_t*)(p.ws + WS_WIN); bf16_t* WoutT = (bf16_t*)(p.ws + WS_WOUT);
#define PREP_LOAD(dst, row) do { const float* _xr = ((row) < NTOK_P) ? p.xp + (size_t)(row) * 1024 : p.xs + (size_t)((row) - NTOK_P) * 1024; \
        dst[0] = __builtin_nontemporal_load((const f32x4*)(_xr + lane * 8)); dst[1] = __builtin_nontemporal_load((const f32x4*)(_xr + lane * 8 + 4)); \
        dst[2] = __builtin_nontemporal_load((const f32x4*)(_xr + 512 + lane * 8)); dst[3] = __builtin_nontemporal_load((const f32x4*)(_xr + 512 + lane * 8 + 4)); } while (0)
#define PREP_DO(v, row) do { float ss = 0.f; \
        _Pragma("unroll") for (int k = 0; k < 4; ++k) _Pragma("unroll") for (int j = 0; j < 4; ++j) ss += v[k][j] * v[k][j]; \
        _Pragma("unroll") for (int o = 32; o >= 1; o >>= 1) ss += __shfl_xor(ss, o); \
        const float rsc = rsqrtf(ss * (1.0f / 1024.0f) + EPS); u32x4 w0, w1; if (lane == 0) { rsb[row] = rsc; rsib[row] = sqrtf(ss * (1.0f / 1024.0f) + EPS); } \
        w0.x = cvt_pk_bf16(v[0][0] * rsc, v[0][1] * rsc); w0.y = cvt_pk_bf16(v[0][2] * rsc, v[0][3] * rsc); w0.z = cvt_pk_bf16(v[1][0] * rsc, v[1][1] * rsc); w0.w = cvt_pk_bf16(v[1][2] * rsc, v[1][3] * rsc); \
        w1.x = cvt_pk_bf16(v[2][0] * rsc, v[2][1] * rsc); w1.y = cvt_pk_bf16(v[2][2] * rsc, v[2][3] * rsc); w1.z = cvt_pk_bf16(v[3][0] * rsc, v[3][1] * rsc); w1.w = cvt_pk_bf16(v[3][2] * rsc, v[3][3] * rsc); \
        *(u32x4*)(xb + (size_t)(row) * 1024 + lane * 8) = w0; *(u32x4*)(xb + (size_t)(row) * 1024 + 512 + lane * 8) = w1; } while (0)
    {
        int row = blockIdx.x * 8 + wid;
        f32x4 va[4], vb[4], vc[4];
        if (row < NTOK) PREP_LOAD(va, row);
        if (row + nw < NTOK) PREP_LOAD(vb, row + nw);
        int itx = 0;
        for (; row < NTOK; row += 3 * nw, ++itx) {
            if (row + 2 * nw < NTOK) PREP_LOAD(vc, row + 2 * nw);
            float wv[8]; const bool wdo = fastw && itx < 4; int wn = 0, wk8 = 0;
            if (wdo) {
                if (itx < 3) { const int idx = gt + itx * T; wn = idx % 3072; wk8 = idx / 3072;
#pragma unroll
                    for (int j = 0; j < 8; ++j) wv[j] = p.w_in[(size_t)(wk8 * 8 + j) * 3072 + wn] * p.norm_g[wk8 * 8 + j]; }
                else { wn = gt % 1024; wk8 = gt / 1024;
#pragma unroll
                    for (int j = 0; j < 8; ++j) wv[j] = p.w_out[(size_t)(wk8 * 8 + j) * 1024 + wn]; }
            }
            PREP_DO(va, row);
            if (row + nw < NTOK) { if (row + 3 * nw < NTOK) PREP_LOAD(va, row + 3 * nw); PREP_DO(vb, row + nw); }
            if (row + 2 * nw < NTOK) { if (row + 4 * nw < NTOK) PREP_LOAD(vb, row + 4 * nw); PREP_DO(vc, row + 2 * nw); }
            if (wdo) { u32x4 w; w.x = cvt_pk_bf16(wv[0], wv[1]); w.y = cvt_pk_bf16(wv[2], wv[3]); w.z = cvt_pk_bf16(wv[4], wv[5]); w.w = cvt_pk_bf16(wv[6], wv[7]);
                *(u32x4*)((itx < 3 ? WinT : WoutT) + (size_t)wn * 1024 + wk8 * 8) = w; }
        }
    }
#undef PREP_LOAD
#undef PREP_DO
    bf16_t* WpT = (bf16_t*)(p.ws + WS_WP);
    if (!fastw)
    for (int idx = gt; idx < 3072 * 128; idx += T) {
        const int n = idx % 3072, k8 = idx / 3072; float v[8];
#pragma unroll
        for (int j = 0; j < 8; ++j) v[j] = p.w_in[(size_t)(k8 * 8 + j) * 3072 + n] * p.norm_g[k8 * 8 + j];
        u32x4 w; w.x = cvt_pk_bf16(v[0], v[1]); w.y = cvt_pk_bf16(v[2], v[3]); w.z = cvt_pk_bf16(v[4], v[5]); w.w = cvt_pk_bf16(v[6], v[7]);
        *(u32x4*)(WinT + (size_t)n * 1024 + k8 * 8) = w;
    }
    if (!fastw)
    for (int idx = gt; idx < 1024 * 128; idx += T) {
        const int n = idx % 1024, k8 = idx / 1024; float v[8];
#pragma unroll
        for (int j = 0; j < 8; ++j) v[j] = p.w_out[(size_t)(k8 * 8 + j) * 1024 + n];
        u32x4 w; w.x = cvt_pk_bf16(v[0], v[1]); w.y = cvt_pk_bf16(v[2], v[3]); w.z = cvt_pk_bf16(v[4], v[5]); w.w = cvt_pk_bf16(v[6], v[7]);
        *(u32x4*)(WoutT + (size_t)n * 1024 + k8 * 8) = w;
    }
    for (int idx = gt; idx < 256 * 128; idx += T) {
        const int n = idx >> 7, k8 = idx & 127; u32x4 w = (u32x4){0u, 0u, 0u, 0u};
        if (k8 == (n >> 3)) { const unsigned one = 0x3F80u << (16 * (n & 1)); const int wd = (n & 7) >> 1; w.x = wd == 0 ? one : 0u; w.y = wd == 1 ? one : 0u; w.z = wd == 2 ? one : 0u; w.w = wd == 3 ? one : 0u; }
        *(u32x4*)((bf16_t*)(p.ws + WS_ID) + (size_t)n * 1024 + k8 * 8) = w;
    }
    for (int idx = gt; idx < 4 * 128 * 16; idx += T) {
        const int d = idx % 128, c8 = (idx / 128) % 16, g = idx / 2048; float v[8];
#pragma unroll
        for (int j = 0; j < 8; ++j) v[j] = p.w_pool[(size_t)(g * 128 + c8 * 8 + j) * 128 + d];
        u32x4 w; w.x = cvt_pk_bf16(v[0], v[1]); w.y = cvt_pk_bf16(v[2], v[3]); w.z = cvt_pk_bf16(v[4], v[5]); w.w = cvt_pk_bf16(v[6], v[7]);
        *(u32x4*)(WpT + (size_t)(g * 128 + d) * 128 + c8 * 8) = w;
    }
}

__device__ __forceinline__ void epi_gemm1(const f32x4 (&acc)[2][2][4][2], const Unit& u, int wr, int wc, int fr, int fq, const Params& p) {
    if (u.pn == 8 || u.pn == 9) {
        bf16_t* VT = (bf16_t*)(p.ws + WS_VT);
        const int gr = u.pm * 4 + wc;
#pragma unroll
        for (int ai = 0; ai < 2; ++ai)
#pragma unroll
            for (int m = 0; m < 4; ++m) {
                const int vc = (u.pn - 8) * 256 + ai * 128 + wr * 64 + m * 16 + fr; const int h = vc >> 6, d = vc & 63;
                bf16_t* dst = VT + ((size_t)(gr * 8 + h) * 64 + d) * 64 + fq * 8;
#pragma unroll
                for (int bj = 0; bj < 2; ++bj) { const f32x4 v0 = acc[ai][bj][m][0], v1 = acc[ai][bj][m][1];
                    u32x4 w; w.x = cvt_pk_bf16(v0[0], v0[1]); w.y = cvt_pk_bf16(v0[2], v0[3]); w.z = cvt_pk_bf16(v1[0], v1[1]); w.w = cvt_pk_bf16(v1[2], v1[3]);
                    __builtin_nontemporal_store(w, (u32x4*)(dst + 32 * bj)); }
            }
    } else {
        const int kind = u.pn < 8 ? (u.pn >> 1) : 4;
        bf16_t* base = (bf16_t*)(p.ws + WS_ACT) + (size_t)kind * ACT_STRIDE;
        const int row0 = u.pm * 256 + wr * 64 + fr, col0 = (u.pn & 1) * 256 + wc * 64 + fq * 8;
        f32x4 gv[2][2];
        if (kind == 2 || kind == 3) { const float* g = kind == 2 ? p.qg : p.kg; const float sc = kind == 2 ? 0.125f : 1.0f;
#pragma unroll
            for (int bj = 0; bj < 2; ++bj)
#pragma unroll
                for (int n = 0; n < 2; ++n) gv[bj][n] = *(const f32x4*)(g + 32 * bj + 8 * fq + 4 * n) * sc; }
#pragma unroll
        for (int ai = 0; ai < 2; ++ai)
#pragma unroll
            for (int m = 0; m < 4; ++m) {
                const int row = row0 + ai * 128 + m * 16;
                f32x4 v[2][2];
#pragma unroll
                for (int bj = 0; bj < 2; ++bj)
#pragma unroll
                    for (int n = 0; n < 2; ++n) v[bj][n] = acc[ai][bj][m][n];
                if (kind == 2 || kind == 3) {
                    float ss = 0.f;
#pragma unroll
                    for (int bj = 0; bj < 2; ++bj)
#pragma unroll
                        for (int n = 0; n < 2; ++n) { const f32x4 x = v[bj][n]; ss += (x[0] * x[0] + x[1] * x[1]) + (x[2] * x[2] + x[3] * x[3]); }
                    ss = xsum4(ss);
                    const float sc = rsqrtf(ss * (1.0f / 64.0f) + EPS);
#pragma unroll
                    for (int bj = 0; bj < 2; ++bj)
#pragma unroll
                        for (int n = 0; n < 2; ++n) v[bj][n] = v[bj][n] * gv[bj][n] * sc;
                } else if (kind == 1 || kind == 4) {
#pragma unroll
                    for (int bj = 0; bj < 2; ++bj)
#pragma unroll
                        for (int n = 0; n < 2; ++n)
#pragma unroll
                            for (int j = 0; j < 4; ++j) v[bj][n][j] = silu_f(v[bj][n][j]);
                }
                bf16_t* dst = base + (size_t)row * 512 + col0;
#pragma unroll
                for (int bj = 0; bj < 2; ++bj) { u32x4 w; w.x = cvt_pk_bf16(v[bj][0][0], v[bj][0][1]); w.y = cvt_pk_bf16(v[bj][0][2], v[bj][0][3]); w.z = cvt_pk_bf16(v[bj][1][0], v[bj][1][1]); w.w = cvt_pk_bf16(v[bj][1][2], v[bj][1][3]);
                    __builtin_nontemporal_store(w, (u32x4*)(dst + 32 * bj)); }
            }
    }
}
__device__ __forceinline__ void epi_gemm2(const f32x4 (&acc)[2][2][4][2], const Unit& u, int wr, int wc, int fr, int fq, const Params& p) {
    const int row0 = u.pm * 256 + wr * 64 + fr, col0 = u.pn * 256 + wc * 32 + 4 * fq;
    const float* rsi = (const float*)(p.ws + WS_RSI) + row0; float ri[2][4];
#pragma unroll
    for (int ai = 0; ai < 2; ++ai)
#pragma unroll
        for (int m = 0; m < 4; ++m) ri[ai][m] = rsi[ai * 128 + m * 16];
#pragma unroll
    for (int ai = 0; ai < 2; ++ai)
#pragma unroll
        for (int m = 0; m < 4; ++m) {
            const int row = row0 + ai * 128 + m * 16;
            float* orow = p.out + (size_t)row * 1024 + col0;
#pragma unroll
            for (int bj = 0; bj < 2; ++bj)
#pragma unroll
                for (int n = 0; n < 2; ++n) *(f32x4*)(orow + bj * 128 + n * 16) = acc[ai][bj][m][n] * ri[ai][m];
        }
}

template <int MODE> __device__ __forceinline__ void acc_init(f32x4 (&acc)[2][2][4][2], const Unit& u, int wr, int wc, int fr, int fq, const Params& p) {
    if (MODE == 0) {
#pragma unroll
        for (int a = 0; a < 2; ++a)
#pragma unroll
            for (int b = 0; b < 2; ++b)
#pragma unroll
                for (int m = 0; m < 4; ++m)
#pragma unroll
                    for (int n = 0; n < 2; ++n) acc[a][b][m][n] = (f32x4){0.f, 0.f, 0.f, 0.f};
    } else {
#pragma unroll
        for (int a = 0; a < 2; ++a)
#pragma unroll
            for (int b = 0; b < 2; ++b)
#pragma unroll
                for (int m = 0; m < 4; ++m)
#pragma unroll
                    for (int n = 0; n < 2; ++n) acc[a][b][m][n] = (f32x4){0.f, 0.f, 0.f, 0.f};
    }
}
template <int MODE>
__device__ __forceinline__ void gemm_phase(LAS unsigned char* lds, const Params& p, const int G, const int c) {
    constexpr int K = 1024, nt = (MODE == 0 ? 16 : 20);
    constexpr int nM = NTOK / 256, nN = (MODE == 0 ? 12 : 4);
    const char* Aop = (const char*)(p.ws + (MODE == 0 ? WS_XB : WS_MIX));
    const char* idm = (const char*)(p.ws + WS_ID) - 16 * (size_t)(BK * 2);
    const char* Bop = (const char*)(p.ws + (MODE == 0 ? WS_WIN : WS_WOUT));
    const int tid = threadIdx.x, wid = __builtin_amdgcn_readfirstlane(tid >> 6), lane = tid & 63, wr = wid >> 2, wc = wid & 3, fr = lane & 15, fq = lane >> 4;
    unsigned voffA[2], voffB[2];
#pragma unroll
    for (int i = 0; i < 2; ++i) { int R, C; stage_rc(tid * 16 + i * 8192, R, C); const int Rb = (MODE == 0) ? (64 * (R >> 5) + perm32(R & 31)) : R;
        voffA[i] = (unsigned)(R * K + C) * 2u; voffB[i] = (unsigned)(Rb * K + C) * 2u; }
    constexpr size_t kstep = (size_t)(BK * 2);
    constexpr size_t hstepA = (size_t)HALF * K * 2;
    constexpr size_t hstepB = (size_t)(MODE == 0 ? 32 : 128) * K * 2;
    constexpr size_t tstep = (size_t)256 * K * 2;
    const unsigned ldsw = (unsigned)wid * 1024u;
    const int aoff = lds_byte(wr * 64 + fr, fq * 8), boff = lds_byte(wc * 32 + fr, fq * 8);
#define PG8_SA(b, h) (((b) * 2 + (h)) * HTB)
#define PG8_SB(b, h) ((4 + (b) * 2 + (h)) * HTB)
#define PG8_STAGE(bufoff, gbase, voff) do { _Pragma("unroll") for (int _i = 0; _i < 2; ++_i) \
        __builtin_amdgcn_global_load_lds((const unsigned*)((const char*)(gbase) + (voff)[_i]), (LAS unsigned*)(lds + (bufoff) + ldsw + _i * 8192), 16, 0, 0); } while (0)
#define PG8_LDA(dst, b, h) do { _Pragma("unroll") for (int m = 0; m < 4; ++m) _Pragma("unroll") for (int k = 0; k < 2; ++k) dst[m][k] = *(const LAS bf16x8*)(lds + PG8_SA(b, h) + aoff + m * 2048 + k * 1024); } while (0)
#define PG8_LDB(dst, b, h) do { _Pragma("unroll") for (int n = 0; n < 2; ++n) _Pragma("unroll") for (int k = 0; k < 2; ++k) dst[n][k] = *(const LAS bf16x8*)(lds + PG8_SB(b, h) + boff + n * 2048 + k * 1024); } while (0)
#define PG8_MMA(ai, bj, At, Bt) do { __builtin_amdgcn_s_setprio(1); _Pragma("unroll") for (int m = 0; m < 4; ++m) _Pragma("unroll") for (int n = 0; n < 2; ++n) _Pragma("unroll") for (int k = 0; k < 2; ++k) \
        acc[ai][bj][m][n] = __builtin_amdgcn_mfma_f32_16x16x32_bf16(Bt[n][k], At[m][k], acc[ai][bj][m][n], 0, 0, 0); __builtin_amdgcn_s_setprio(0); } while (0)
#define PG8_WAIT_V(n) asm volatile("s_waitcnt vmcnt(" #n ")" ::: "memory")
#define PG8_WAIT_L(n) asm volatile("s_waitcnt lgkmcnt(" #n ")" ::: "memory")
#define PG8_BAR __builtin_amdgcn_s_barrier()
#define PG8_SCHED __builtin_amdgcn_sched_barrier(0)
#define UNIT_PTRS(u, pa, pb) do { if (MODE == 0 && ((u).pn == 8 || (u).pn == 9)) { pa = Bop + (size_t)(u).pn * tstep; pb = Aop + (size_t)(u).pm * tstep; } \
        else { pa = Aop + (size_t)(u).pm * tstep; pb = Bop + (size_t)(u).pn * tstep; } } while (0)
    Unit cur, nxt; int ui = 0;
    if (!unit_next<nM, nN>(0, G, c, cur)) return;
    f32x4 acc[2][2][4][2];
    acc_init<MODE>(acc, cur, wr, wc, fr, fq, p);
    bf16x8 At[4][2], B0[2][2], B1[2][2];
    const char* cA; const char* cB; UNIT_PTRS(cur, cA, cB);
#define UNIT_X(u) ((const char*)(p.ws + WS_XB) + (size_t)(u).pm * tstep + (size_t)(u).pn * 512 - 16 * kstep)
    const char* cX = UNIT_X(cur);
    PG8_STAGE(PG8_SB(0, 0), cB, voffB); PG8_STAGE(PG8_SA(0, 0), cA, voffA); PG8_STAGE(PG8_SB(0, 1), cB + hstepB, voffB); PG8_STAGE(PG8_SA(0, 1), cA + hstepA, voffA);
    if (wr == 1) PG8_BAR;
    PG8_WAIT_V(4); PG8_BAR;
    PG8_STAGE(PG8_SB(1, 0), cB + kstep, voffB); PG8_STAGE(PG8_SA(1, 0), cA + kstep, voffA); PG8_STAGE(PG8_SB(1, 1), cB + hstepB + kstep, voffB);
    PG8_WAIT_V(6); PG8_BAR;
    for (;;) {
        const bool has_next = unit_next<nM, nN>(ui + 1, G, c, nxt);
        const char* nA = cA; const char* nB = cB; if (has_next) UNIT_PTRS(nxt, nA, nB);
        const char* nX = has_next ? UNIT_X(nxt) : cX;
        for (int t = 0; t < nt; t += 2) {
            const bool last = (t == nt - 2);
            const bool xs1 = (MODE == 1) && (t >= 16), xs2 = (MODE == 1) && (t + 2 >= 16);
            const char* a1 = (xs1 ? cX : cA) + (size_t)(t + 1) * kstep;
            const char* a2 = last ? nA : (xs2 ? cX : cA) + (size_t)(t + 2) * kstep; const char* b2 = last ? nB : (xs2 ? idm : cB) + (size_t)(t + 2) * kstep;
            const char* a3 = a2 + kstep; const char* b3 = b2 + kstep;
            PG8_LDB(B0, 0, 0); PG8_SCHED; PG8_LDA(At, 0, 0); PG8_STAGE(PG8_SA(1, 1), a1 + hstepA, voffA);
            PG8_WAIT_L(8); PG8_BAR; PG8_WAIT_L(0); PG8_MMA(0, 0, At, B0); PG8_BAR; PG8_SCHED;
            PG8_LDB(B1, 0, 1); PG8_STAGE(PG8_SB(0, 0), b2, voffB);
            PG8_BAR; PG8_WAIT_L(0); PG8_MMA(0, 1, At, B1); PG8_BAR;
            PG8_LDA(At, 0, 1); PG8_STAGE(PG8_SA(0, 0), a2, voffA);
            PG8_BAR; PG8_WAIT_L(0); PG8_MMA(1, 0, At, B0); PG8_BAR; PG8_SCHED;
            PG8_STAGE(PG8_SB(0, 1), b2 + hstepB, voffB);
            PG8_WAIT_V(6); PG8_BAR; PG8_MMA(1, 1, At, B1); PG8_BAR;
            PG8_LDB(B0, 1, 0); PG8_SCHED; PG8_LDA(At, 1, 0); PG8_STAGE(PG8_SA(0, 1), a2 + hstepA, voffA);
            PG8_WAIT_L(8); PG8_BAR; PG8_WAIT_L(0); PG8_MMA(0, 0, At, B0); PG8_BAR; PG8_SCHED;
            PG8_LDB(B1, 1, 1); PG8_STAGE(PG8_SB(1, 0), b3, voffB);
            PG8_BAR; PG8_WAIT_L(0); PG8_MMA(0, 1, At, B1); PG8_BAR;
            PG8_LDA(At, 1, 1); PG8_STAGE(PG8_SA(1, 0), a3, voffA);
            PG8_BAR; PG8_WAIT_L(0); PG8_MMA(1, 0, At, B0); PG8_BAR; PG8_SCHED;
            PG8_STAGE(PG8_SB(1, 1), b3 + hstepB, voffB);
            PG8_WAIT_V(6); PG8_BAR; PG8_MMA(1, 1, At, B1); PG8_BAR;
        }
        if (MODE == 0) epi_gemm1(acc, cur, wr, wc, fr, fq, p); else epi_gemm2(acc, cur, wr, wc, fr, fq, p);
        if (!has_next) break;
        acc_init<MODE>(acc, nxt, wr, wc, fr, fq, p);
        cur = nxt; cA = nA; cB = nB; cX = nX; ++ui;
    }
    PG8_WAIT_V(0);
    if (wr == 0) PG8_BAR;
    PG8_BAR;
#undef PG8_SA
#undef PG8_SB
#undef PG8_STAGE
#undef PG8_LDA
#undef PG8_LDB
#undef PG8_MMA
#undef UNIT_PTRS
#undef UNIT_X
}

constexpr int PSTR = 1040;
constexpr int RPB_OFF = 147456;
#define SCHED_FENCE __builtin_amdgcn_sched_barrier(0)
__device__ __forceinline__ void acc8(float (&a)[8], u32x4 w, const float sgn) { asm("" : "+v"(w));
    a[0] += sgn * bf_lo(w.x); a[1] += sgn * bf_hi(w.x); a[2] += sgn * bf_lo(w.y); a[3] += sgn * bf_hi(w.y);
    a[4] += sgn * bf_lo(w.z); a[5] += sgn * bf_hi(w.z); a[6] += sgn * bf_lo(w.w); a[7] += sgn * bf_hi(w.w);
}
template <int A> __device__ __forceinline__ void pool_a(LAS unsigned char* ldsdst, const bf16_t* Ub, const int pos0, const int S) {
    constexpr int NR = 8 + 2 * A - 1;
    u32x4 rows[NR];
#pragma unroll
    for (int j = 0; j < NR; ++j) { const int pos = pos0 - A + j; const int pc = pos < 0 ? 0 : (pos >= S ? S - 1 : pos); rows[j] = *(const u32x4*)(Ub + (size_t)pc * 512); }
    SCHED_FENCE;
#pragma unroll
    for (int j = 0; j < NR; ++j) { const int pos = pos0 - A + j; if (pos < 0 || pos >= S) rows[j] = (u32x4){0u, 0u, 0u, 0u}; }
    float acc[8];
#pragma unroll
    for (int j = 0; j < 8; ++j) acc[j] = 0.f;
#pragma unroll
    for (int j = 0; j < 2 * A; ++j) acc8(acc, rows[j], 1.0f);
#pragma unroll
    for (int t = 0; t < 8; ++t) {
        const int pos = pos0 + t; const int hi = (pos + A < S) ? pos + A : S, lo = (pos - A > 0) ? pos - A : 0;
        const float inv = 1.0f / (float)(hi - lo);
        const u32x4 cw = rows[A + t];
        float o[8];
        o[0] = acc[0] * inv - bf_lo(cw.x); o[1] = acc[1] * inv - bf_hi(cw.x); o[2] = acc[2] * inv - bf_lo(cw.y); o[3] = acc[3] * inv - bf_hi(cw.y);
        o[4] = acc[4] * inv - bf_lo(cw.z); o[5] = acc[5] * inv - bf_hi(cw.z); o[6] = acc[6] * inv - bf_lo(cw.w); o[7] = acc[7] * inv - bf_hi(cw.w);
        u32x4 w; w.x = cvt_pk_bf16(o[0], o[1]); w.y = cvt_pk_bf16(o[2], o[3]); w.z = cvt_pk_bf16(o[4], o[5]); w.w = cvt_pk_bf16(o[6], o[7]);
        *(LAS u32x4*)(ldsdst + t * PSTR) = w;
        if (t < 7) { acc8(acc, rows[2 * A + t], 1.0f); acc8(acc, rows[t], -1.0f); }
    }
}
__device__ __forceinline__ void mixer_phase(LAS unsigned char* lds, const Params& p, const int G, const int c) {
    const int tid = threadIdx.x, lane = tid & 63, wid = __builtin_amdgcn_readfirstlane(tid >> 6), fr = lane & 15, fq = lane >> 4;
    const bf16_t* aU = (const bf16_t*)(p.ws + WS_ACT); const bf16_t* aGP = aU + ACT_STRIDE; const bf16_t* aQ = aU + 2 * ACT_STRIDE; const bf16_t* aK = aU + 3 * ACT_STRIDE; const bf16_t* aGA = aU + 4 * ACT_STRIDE;
    const bf16_t* VT = (const bf16_t*)(p.ws + WS_VT); const bf16_t* WpT = (const bf16_t*)(p.ws + WS_WP);
    bf16_t* MIX = (bf16_t*)(p.ws + WS_MIX); const float* rsb = (const float*)(p.ws + WS_RS);
    LAS float* rpbs = (LAS float*)(lds + RPB_OFF);
    for (int i = tid; i < 8 * 465; i += 512) rpbs[i] = p.rpb[i];
    __syncthreads();
    bf16x8 bfr[4][4]; f32x4 psv[4];
    {
        const int g = wid >> 1, dh = wid & 1;
        const bf16_t* wb = WpT + (size_t)(g * 128 + 64 * dh + fr) * 128 + 8 * fq;
#pragma unroll
        for (int nt = 0; nt < 4; ++nt)
#pragma unroll
            for (int ks = 0; ks < 4; ++ks) bfr[nt][ks] = *(const bf16x8*)(wb + nt * 16 * 128 + 32 * ks);
#pragma unroll
        for (int nt = 0; nt < 4; ++nt) psv[nt] = *(const f32x4*)(p.pool_scale + 128 * g + 64 * dh + 16 * nt + 4 * fq);
    }
    for (int it = 0;; ++it) {
        const int L = it * G + c; if (L >= 1280) break;
        const int gr = (L & 7) * 160 + (L >> 3);
        int R, r; if (gr < 1024) { R = 64; r = gr & 63; } else { R = 128; r = (gr - 1024) & 127; }
        const int gr0 = gr - r; const int S = R * 64;
        {
            const int g = wid >> 1, th = wid & 1;
            const int c0 = 128 * g + 8 * fr, tl0 = 32 * th + 8 * fq, pos0 = r * 64 + tl0;
            const bf16_t* Ub = aU + (size_t)gr0 * 64 * 512 + c0;
            LAS unsigned char* dst = lds + (it & 1) * (64 * PSTR) + tl0 * PSTR + c0 * 2;
            if (g == 0) pool_a<1>(dst, Ub, pos0, S); else if (g == 1) pool_a<2>(dst, Ub, pos0, S); else if (g == 2) pool_a<4>(dst, Ub, pos0, S); else pool_a<8>(dst, Ub, pos0, S);
        }
        {
            const int g = wid >> 1, dh = wid & 1;
            u32x2 gw[4][4];
            const bf16_t* gb = aGP + ((size_t)gr * 64 + fr) * 512 + 128 * g + 64 * dh + 4 * fq;
#pragma unroll
            for (int mt = 0; mt < 4; ++mt)
#pragma unroll
                for (int nt = 0; nt < 4; ++nt) gw[mt][nt] = *(const u32x2*)(gb + (size_t)mt * 16 * 512 + 16 * nt);
            float rsm[4];
#pragma unroll
            for (int mt = 0; mt < 4; ++mt) rsm[mt] = rsb[(size_t)gr * 64 + 16 * mt + fr];
            SCHED_FENCE;
            __syncthreads();
            f32x4 acc[4][4];
#pragma unroll
            for (int mt = 0; mt < 4; ++mt)
#pragma unroll
                for (int nt = 0; nt < 4; ++nt) acc[mt][nt] = (f32x4){0.f, 0.f, 0.f, 0.f};
#pragma unroll
            for (int ks = 0; ks < 4; ++ks) {
                bf16x8 af[4];
#pragma unroll
                for (int mt = 0; mt < 4; ++mt) af[mt] = *(const LAS bf16x8*)(lds + (it & 1) * (64 * PSTR) + (16 * mt + fr) * PSTR + (128 * g + 32 * ks + 8 * fq) * 2);
#pragma unroll
                for (int mt = 0; mt < 4; ++mt)
#pragma unroll
                    for (int nt = 0; nt < 4; ++nt) acc[mt][nt] = __builtin_amdgcn_mfma_f32_16x16x32_bf16(bfr[nt][ks], af[mt], acc[mt][nt], 0, 0, 0);
            }
            bf16_t* mb = MIX + ((size_t)gr * 64 + fr) * 1024 + 128 * g + 64 * dh + 4 * fq;
#pragma unroll
            for (int mt = 0; mt < 4; ++mt)
#pragma unroll
                for (int nt = 0; nt < 4; ++nt) {
                    const f32x4 a4 = acc[mt][nt] * rsm[mt]; const u32x2 gg = gw[mt][nt];
                    u32x2 w; w.x = cvt_pk_bf16(a4[0] * psv[nt][0] * bf_lo(gg.x), a4[1] * psv[nt][1] * bf_hi(gg.x)); w.y = cvt_pk_bf16(a4[2] * psv[nt][2] * bf_lo(gg.y), a4[3] * psv[nt][3] * bf_hi(gg.y));
                    *(u32x2*)(mb + (size_t)mt * 16 * 1024 + 16 * nt) = w;
                }
        }
    }
    __syncthreads();
}
constexpr int VREG = 73728;
#define A_BAR() do { SCHED_FENCE; asm volatile("s_waitcnt lgkmcnt(0)" ::: "memory"); __builtin_amdgcn_s_barrier(); SCHED_FENCE; } while (0)
__device__ __forceinline__ void gload16_asm(bf16x8& v, const void* ptr) { asm volatile("global_load_dwordx4 %0, %1, off" : "=v"(v) : "v"(ptr) : "memory"); }
__device__ __forceinline__ void gload4_asm(float& v, const void* ptr) { asm volatile("global_load_dword %0, %1, off" : "=v"(v) : "v"(ptr) : "memory"); }
__device__ __forceinline__ void gload8_asm(u32x2& v, const void* ptr) { asm volatile("global_load_dwordx2 %0, %1, off" : "=v"(v) : "v"(ptr) : "memory"); }
struct AUnit { int gr0, R, r0, h, gA, win; };
__device__ __forceinline__ int win_start(int r, int R) { int s = r - 4; s = s < 0 ? 0 : s; return s > R - 8 ? R - 8 : s; }
__device__ __forceinline__ void attn_decode(int L, int G, AUnit& u) {
    int pp;
    if (G == 256) { const int it = L >> 8, c = L & 255, xcd = c & 7, j = c >> 3; u.h = j & 7; pp = 80 * xcd + 20 * (j >> 3) + it; }
    else { const int xcd = L & 7, q = L >> 3; pp = 80 * xcd + (q >> 3); u.h = q & 7; }
    u.gA = 2 * pp;
    if (u.gA < 1024) { u.R = 64; u.r0 = u.gA & 63; } else { u.R = 128; u.r0 = (u.gA - 1024) & 127; }
    u.gr0 = u.gA - u.r0; u.win = win_start(u.r0, u.R);
}
__device__ __forceinline__ void stage_K(LAS unsigned char* lds, const bf16_t* aK, const AUnit& u, int wid, int lane, int pa) {
    const int rsU = u.win; const int col = 8 * wid + (lane >> 3); const int ch = (lane & 7) ^ ((col >> 1) & 7);
    const bf16_t* src = aK + (size_t)col * 512 + u.h * 64 + ch * 8;
#pragma unroll
    for (int m = 0; m < 9; ++m) { int rw = rsU + m; rw = rw > u.R - 1 ? u.R - 1 : rw;
        if (rw < pa || rw > pa + 8) __builtin_amdgcn_global_load_lds((const unsigned*)(src + (size_t)(u.gr0 + rw) * 64 * 512), (LAS unsigned*)(lds + (wid + 8 * (rw % 9)) * 1024), 16, 0, 0); }
}
__device__ __forceinline__ void stage_V(LAS unsigned char* lds, const bf16_t* VT, const AUnit& u, int wid, int lane, int pa) {
    const int rsU = u.win; const int d = 8 * wid + (lane >> 3); const int ch = (lane & 7) ^ ((d >> 1) & 7);
    const bf16_t* src = VT + (size_t)u.h * 4096 + d * 64 + ch * 8;
#pragma unroll
    for (int m = 0; m < 9; ++m) { int rw = rsU + m; rw = rw > u.R - 1 ? u.R - 1 : rw;
        if (rw < pa || rw > pa + 8) __builtin_amdgcn_global_load_lds((const unsigned*)(src + (size_t)(u.gr0 + rw) * 8 * 4096), (LAS unsigned*)(lds + VREG + (wid + 8 * (rw % 9)) * 1024), 16, 0, 0); }
}
__device__ __forceinline__ void attn_phase(LAS unsigned char* lds, const Params& p, const int G, const int c) {
    const int tid = threadIdx.x, lane = tid & 63, wid = __builtin_amdgcn_readfirstlane(tid >> 6), fr = lane & 15, fq = lane >> 4;
    const bf16_t* aU = (const bf16_t*)(p.ws + WS_ACT); const bf16_t* aQ = aU + 2 * ACT_STRIDE; const bf16_t* aK = aU + 3 * ACT_STRIDE; const bf16_t* aGA = aU + 4 * ACT_STRIDE;
    const bf16_t* VT = (const bf16_t*)(p.ws + WS_VT);
    bf16_t* MIX = (bf16_t*)(p.ws + WS_MIX); const float* rsb = (const float*)(p.ws + WS_RS);
    const LAS float* rpbs = (const LAS float*)(lds + RPB_OFF);
    const int sel = wid >> 2, qb = wid & 3;
    const int ws_ = (qb == 0) ? 0 : (qb == 1) ? 8 : (qb == 2) ? 24 : 32;
    int kofs[2][2], vofs[4];
#pragma unroll
    for (int t = 0; t < 2; ++t) { const int kc = ws_ + 8 * (fr >> 2) + 4 * t + (fr & 3); const int sw = (kc >> 1) & 7; kofs[t][0] = kc * 128 + ((fq ^ sw) << 4); kofs[t][1] = kc * 128 + (((fq | 4) ^ sw) << 4); }
#pragma unroll
    for (int dt = 0; dt < 4; ++dt) { const int d = 16 * dt + fr; vofs[dt] = VREG + d * 128 + ((((ws_ >> 3) + fq) ^ ((d >> 1) & 7)) << 4); }
    const int cq = 16 * qb + fr; int cs = cq - 8; cs = cs < 0 ? 0 : cs; cs = cs > 48 ? 48 : cs;
    int L = c; if (L >= 5120) return;
    if (wid >= 4) __builtin_amdgcn_s_setprio(1);
    AUnit cur, nxt; attn_decode(L, G, cur);
    stage_K(lds, aK, cur, wid, lane, -100);
    int pgr0 = -1, pwin = 0;
    size_t qtok = (size_t)(cur.gA + sel) * 64 + 16 * qb + fr;
    bf16x8 qf0, qf1; u32x2 gw[4];
    SCHED_FENCE;
    gload16_asm(qf0, aQ + qtok * 512 + cur.h * 64 + 8 * fq); gload16_asm(qf1, aQ + qtok * 512 + cur.h * 64 + 32 + 8 * fq);
#pragma unroll
    for (int dt = 0; dt < 4; ++dt) gload8_asm(gw[dt], aGA + qtok * 512 + cur.h * 64 + 16 * dt + 4 * fq);
    float rsq; gload4_asm(rsq, rsb + qtok);
    SCHED_FENCE;
    SCHED_FENCE; asm volatile("s_waitcnt vmcnt(0)" ::: "memory"); SCHED_FENCE;
    for (;;) {
        const int r = cur.r0 + sel; const int rs0 = win_start(r, cur.R); const int sb = rs0 % 9;
        const LAS float* rb = rpbs + cur.h * 465 + (rs0 - r + 7) * 31;
        const int h = cur.h;
        SCHED_FENCE; asm volatile("s_waitcnt vmcnt(4) lgkmcnt(0)" ::: "memory"); __builtin_amdgcn_s_barrier(); SCHED_FENCE;
        asm volatile("" : "+v"(qf0), "+v"(qf1)); SCHED_FENCE;
        stage_V(lds, VT, cur, wid, lane, (pgr0 == cur.gr0) ? pwin : -100);
        pgr0 = cur.gr0; pwin = cur.win;
        SCHED_FENCE;
        const int Ln = L + G; const bool has_next = Ln < 5120;
        nxt = cur; if (has_next) attn_decode(Ln, G, nxt);
        const size_t qtok_n = (size_t)(nxt.gA + sel) * 64 + 16 * qb + fr;
        bf16x8 qn0, qn1; u32x2 gn[4];
        gload16_asm(qn0, aQ + qtok_n * 512 + nxt.h * 64 + 8 * fq); gload16_asm(qn1, aQ + qtok_n * 512 + nxt.h * 64 + 32 + 8 * fq);
#pragma unroll
        for (int dt = 0; dt < 4; ++dt) gload8_asm(gn[dt], aGA + qtok_n * 512 + nxt.h * 64 + 16 * dt + 4 * fq);
        float rsn; gload4_asm(rsn, rsb + qtok_n);
        SCHED_FENCE;
        f32x4 s[8][2];
        {
            const LAS unsigned char* kb = lds;
#pragma unroll
            for (int i = 0; i < 8; ++i)
#pragma unroll
                for (int t = 0; t < 2; ++t) {
                    const int so = ((sb + i >= 9) ? sb + i - 9 : sb + i) * 8192;
                    const bf16x8 k0 = *(const LAS bf16x8*)(kb + kofs[t][0] + so), k1 = *(const LAS bf16x8*)(kb + kofs[t][1] + so);
                    f32x4 z = (f32x4){0.f, 0.f, 0.f, 0.f};
                    z = __builtin_amdgcn_mfma_f32_16x16x32_bf16(k0, qf0, z, 0, 0, 0);
                    z = __builtin_amdgcn_mfma_f32_16x16x32_bf16(k1, qf1, z, 0, 0, 0);
                    s[i][t] = z;
                }
        }
        typedef float f32x2 __attribute__((ext_vector_type(2)));
        f32x2 sv[8][2][2];
        float mx = -1e30f;
#pragma unroll
        for (int t = 0; t < 2; ++t)
#pragma unroll
            for (int jp = 0; jp < 2; ++jp) {
                f32x2 mk1, mk2; int bi2[2];
#pragma unroll
                for (int e = 0; e < 2; ++e) { const int j = 2 * jp + e; const int kc = ws_ + 8 * fq + 4 * t + j; const bool valid = (kc >= cs) && (kc < cs + 16);
                    int bi = kc - cq + 15; bi = bi < 0 ? 0 : bi; bi = bi > 30 ? 30 : bi; bi2[e] = bi; mk1[e] = valid ? 1.0f : 0.0f; mk2[e] = valid ? 0.0f : -1e30f; }
#pragma unroll
                for (int i = 0; i < 8; ++i) { f32x2 bb; bb.x = rb[i * 31 + bi2[0]]; bb.y = rb[i * 31 + bi2[1]];
                    f32x2 x; x.x = s[i][t][2 * jp]; x.y = s[i][t][2 * jp + 1];
                    const f32x2 v = (x + bb) * mk1 + mk2; sv[i][t][jp] = v; mx = fmaxf(mx, fmaxf(v.x, v.y)); }
            }
        mx = xmax4(mx);
        const float mxl = mx * 1.44269504f;
        const f32x2 c2 = (f32x2){1.44269504f, 1.44269504f}, m2 = (f32x2){-mxl, -mxl};
        f32x2 sum2 = (f32x2){0.f, 0.f};
#pragma unroll
        for (int i = 0; i < 8; ++i)
#pragma unroll
            for (int t = 0; t < 2; ++t)
#pragma unroll
                for (int jp = 0; jp < 2; ++jp) { const f32x2 a2 = sv[i][t][jp] * c2 + m2; f32x2 e; e.x = __builtin_amdgcn_exp2f(a2.x); e.y = __builtin_amdgcn_exp2f(a2.y);
                    s[i][t][2 * jp] = e.x; s[i][t][2 * jp + 1] = e.y; sum2 += e; }
        float sum = sum2.x + sum2.y;
        sum = xsum4(sum);
        const float inv0 = 1.0f / sum;
        bf16x8 pf[8];
#pragma unroll
        for (int i = 0; i < 8; ++i) {
            u32x4 pw; pw.x = cvt_pk_bf16(s[i][0][0], s[i][0][1]); pw.y = cvt_pk_bf16(s[i][0][2], s[i][0][3]);
            pw.z = cvt_pk_bf16(s[i][1][0], s[i][1][1]); pw.w = cvt_pk_bf16(s[i][1][2], s[i][1][3]);
            pf[i] = __builtin_bit_cast(bf16x8, pw);
        }
        SCHED_FENCE; asm volatile("s_waitcnt vmcnt(0) lgkmcnt(0)" ::: "memory"); __builtin_amdgcn_s_barrier(); SCHED_FENCE;
        stage_K(lds, aK, nxt, wid, lane, (nxt.gr0 == cur.gr0) ? cur.win : -100);
        SCHED_FENCE;
        asm volatile("" : "+v"(qn0), "+v"(qn1), "+v"(gn[0]), "+v"(gn[1]), "+v"(gn[2]), "+v"(gn[3]), "+v"(gw[0]), "+v"(gw[1]), "+v"(gw[2]), "+v"(gw[3]), "+v"(rsn), "+v"(rsq)); SCHED_FENCE;
        f32x4 o[4];
#pragma unroll
        for (int dt = 0; dt < 4; ++dt) o[dt] = (f32x4){0.f, 0.f, 0.f, 0.f};
        {
            const LAS unsigned char* vb = lds;
#pragma unroll
            for (int i = 0; i < 8; ++i)
#pragma unroll
                for (int dt = 0; dt < 4; ++dt) { const int so = ((sb + i >= 9) ? sb + i - 9 : sb + i) * 8192;
                    const bf16x8 vf = *(const LAS bf16x8*)(vb + vofs[dt] + so); o[dt] = __builtin_amdgcn_mfma_f32_16x16x32_bf16(vf, pf[i], o[dt], 0, 0, 0); }
        }
#pragma unroll
        for (int dt = 0; dt < 4; ++dt) {
            const int chn = h * 64 + 16 * dt + 4 * fq;
            const float inv = inv0 * rsq;
            u32x2 w; w.x = cvt_pk_bf16(o[dt][0] * inv * bf_lo(gw[dt].x), o[dt][1] * inv * bf_hi(gw[dt].x)); w.y = cvt_pk_bf16(o[dt][2] * inv * bf_lo(gw[dt].y), o[dt][3] * inv * bf_hi(gw[dt].y));
            *(u32x2*)(MIX + qtok * 1024 + 512 + chn) = w;
        }
        if (!has_next) break;
        cur = nxt; L = Ln; qtok = qtok_n; qf0 = qn0; qf1 = qn1; rsq = rsn;
#pragma unroll
        for (int dt = 0; dt < 4; ++dt) gw[dt] = gn[dt];
    }
    asm volatile("s_waitcnt vmcnt(0)" ::: "memory"); __builtin_amdgcn_s_barrier();
    __builtin_amdgcn_s_setprio(0);
}


}
__global__ void __launch_bounds__(512, 2) fwd_kernel(Params p) {
    extern __shared__ __attribute__((aligned(16))) unsigned char shm[];
    LAS unsigned char* lds = (LAS unsigned char*)shm;
    const int G = gridDim.x, c = blockIdx.x;
    cg::grid_group grid = cg::this_grid();
#ifndef REP0
#define REP0 1
#endif
#ifndef REP1
#define REP1 1
#endif
#ifndef REP2
#define REP2 1
#endif
#ifndef REP3
#define REP3 1
#endif
    volatile LAS unsigned* bst = (volatile LAS unsigned*)(lds + 147456 + 8 * 465 * 4);
    if (threadIdx.x < 2) bst[threadIdx.x] = 0u;
    __syncthreads();
    XcdBarrier xbar = xcd_barrier_post((unsigned*)(p.ws + WS_BAR), bst);
#define GRID_SYNC() do { if (p.coop) { if (p.use_cg) grid.sync(); else xcd_barrier(xbar); } } while (0)
    if (p.ph_lo <= 0 && 0 < p.ph_hi) { for (int rep = 0; rep < REP0; ++rep) { prep_phase(p, G); GRID_SYNC(); } }
    if (p.ph_lo <= 1 && 1 < p.ph_hi) { for (int rep = 0; rep < REP1; ++rep) { gemm_phase<0>(lds, p, G, c); GRID_SYNC(); } }
    if (p.ph_lo <= 2 && 2 < p.ph_hi) { for (int rep = 0; rep < REP2; ++rep) { mixer_phase(lds, p, G, c); attn_phase(lds, p, G, c); GRID_SYNC(); } }
    if (p.ph_lo <= 3 && 3 < p.ph_hi) { for (int rep = 0; rep < REP3; ++rep) { gemm_phase<1>(lds, p, G, c); if (REP3 > 1 && p.coop) grid.sync(); } }
}

#ifndef N_LAUNCHES
#define N_LAUNCHES 1
#endif

extern "C" void kernel_launch(void* const* d_in, const int* in_sizes, int n_in, void* d_out, int out_size, void* d_ws, size_t ws_size, hipStream_t stream) {
    static int grid = 0;
    if (grid == 0) {
        if (n_in != 10 || ws_size < WS_END) { fprintf(stderr, "kernel_launch: unexpected inputs (n_in %d, ws %zu < %zu)\n", n_in, ws_size, (size_t)WS_END); grid = -1; return; }
        int dev = 0, cus = 0, per_cu = 0;
        (void)hipGetDevice(&dev); (void)hipDeviceGetAttribute(&cus, hipDeviceAttributeMultiprocessorCount, dev);
        if (hipFuncSetAttribute((const void*)fwd_kernel, hipFuncAttributeMaxDynamicSharedMemorySize, LDS_BYTES) != hipSuccess) { fprintf(stderr, "kernel_launch: hipFuncSetAttribute failed\n"); grid = -1; return; }
        (void)hipOccupancyMaxActiveBlocksPerMultiprocessor(&per_cu, (const void*)fwd_kernel, 512, LDS_BYTES);
        (void)hipGetLastError();
        if (per_cu < 1) per_cu = 1;
        grid = cus;
    }
    if (grid < 0) return;
    Params p{};
    p.xp = (const float*)d_in[0]; p.xs = (const float*)d_in[1]; p.norm_g = (const float*)d_in[2]; p.w_in = (const float*)d_in[3]; p.w_pool = (const float*)d_in[4];
    p.pool_scale = (const float*)d_in[5]; p.qg = (const float*)d_in[6]; p.kg = (const float*)d_in[7]; p.rpb = (const float*)d_in[8]; p.w_out = (const float*)d_in[9];
    p.out = (float*)d_out; p.ws = (unsigned char*)d_ws; p.use_cg = 0;
    (void)hipMemsetAsync((char*)d_ws + WS_BAR, 0, XCD_BAR_WORDS * 4, stream);
#if N_LAUNCHES == 1
    p.ph_lo = 0; p.ph_hi = 4; p.coop = 1;
    void* args[] = {&p};
    hipError_t e = hipLaunchCooperativeKernel((const void*)fwd_kernel, dim3(grid), dim3(512), args, LDS_BYTES, stream);
    if (e != hipSuccess) fprintf(stderr, "cooperative launch failed: %s (grid %d)\n", hipGetErrorString(e), grid);
#else
    for (int ph = 0; ph < 4; ++ph) { p.ph_lo = ph; p.ph_hi = ph + 1; p.coop = 0; hipLaunchKernelGGL(fwd_kernel, dim3(grid), dim3(512), LDS_BYTES, stream, p); }
#endif
}
```
